# Optimizing an MI355X kernel written in HIP

```python
import math
import jax
import jax.numpy as jnp
from jax import lax
import numpy as np

D_MODEL = 1024
BATCH = 4
SEQ = 4096
DEPTH = 4

GRID_W = 64
CTX_LEN = 256

MIXERS = ('pool', 'attn', 'ssm', 'gmlp')
N_MIXERS = len(MIXERS)
CTX_READING_MIXERS = ('attn', 'ssm')

DEEPNORM_ALPHA = (2.0 * DEPTH) ** 0.25
DEEPNORM_BETA = (8.0 * DEPTH) ** -0.25
LN_EPS = 1e-5
N_MODS = 6

POOL_WINDOWS = (2, 4, 8, 16)
N_POOL_GROUPS = len(POOL_WINDOWS)
POOL_GROUP = D_MODEL // N_POOL_GROUPS

HEAD_DIM = 64
N_Q_HEADS = D_MODEL // HEAD_DIM
N_KV_HEADS = N_Q_HEADS // 4
GQA_GROUP = N_Q_HEADS // N_KV_HEADS
Q_WIDTH = N_Q_HEADS * HEAD_DIM
KV_WIDTH = N_KV_HEADS * HEAD_DIM
WINDOW = 128
ATTN_BLOCK = 128
ROPE_BASE = 10000.0
NEG_INF = -1e30

SSM_GROUP = 16
SSM_N_GROUPS = D_MODEL // SSM_GROUP
SSM_STATE = 64
DT_MIN = 1e-3
DT_MAX = 1e-1

GMLP_CHUNK = 128
GMLP_HALF = 2 * D_MODEL
GMLP_HEADS = 8
GMLP_HEAD_DIM = GMLP_HALF // GMLP_HEADS

FFN_HIDDEN = 2816
CONV_WIDTH = 3

kernel_name = 'hybrid_interleaved_diffusion_trunk'


def layer_norm(x, g, b):
    xf = x.astype(jnp.float32)
    mu = jnp.mean(xf, axis=-1, keepdims=True)
    var = jnp.mean(jnp.square(xf - mu), axis=-1, keepdims=True)
    y = (xf - mu) * lax.rsqrt(var + LN_EPS) * g.astype(jnp.float32) + b.astype(jnp.float32)
    return y.astype(x.dtype)


def modulate(x, shift, scale):
    return x * (1.0 + scale) + shift


def ada_modulations(cond, w, b):
    return jnp.split(jax.nn.silu(cond) @ w + b, N_MODS, axis=-1)


def post_norm_residual(x, y, gate, g, b):
    return layer_norm(DEEPNORM_ALPHA * x + gate * y, g, b)


def pool_mixer(h, w, b, scale):
    bsz, n, _ = h.shape
    hf = h.astype(jnp.float32)
    csum = jnp.concatenate([jnp.zeros_like(hf[:, :1]), lax.cumsum(hf, axis=1)], axis=1)
    csum = csum.reshape(bsz, n + 1, N_POOL_GROUPS, POOL_GROUP)
    pos = jnp.arange(n)[:, None]
    win = jnp.array(POOL_WINDOWS)[None, :]
    lo = jnp.clip(pos - win // 2, 0, n)
    hi = jnp.clip(pos - win // 2 + win, 0, n)
    grp = jnp.arange(N_POOL_GROUPS)[None, :]
    mean = (csum[:, hi, grp] - csum[:, lo, grp]) / (hi - lo).astype(jnp.float32)[None, :, :, None]
    mixed = mean - hf.reshape(bsz, n, N_POOL_GROUPS, POOL_GROUP)
    y = jnp.einsum('bngc,gcd->bngd', mixed.astype(h.dtype), w) + b.reshape(N_POOL_GROUPS, POOL_GROUP)
    return y.reshape(bsz, n, D_MODEL) * scale


def rope_1d(x, pos):
    half = x.shape[-1] // 2
    freqs = ROPE_BASE ** (-jnp.arange(half, dtype=jnp.float32) / half)
    ang = pos.astype(jnp.float32)[:, None] * freqs[None, :]
    cos = jnp.cos(ang)[None, :, None, :]
    sin = jnp.sin(ang)[None, :, None, :]
    xf = x.astype(jnp.float32)
    x1, x2 = xf[..., :half], xf[..., half:]
    return jnp.concatenate([x1 * cos - x2 * sin, x1 * sin + x2 * cos], axis=-1).astype(x.dtype)


def axial_rope(x, row_pos, col_pos):
    half = HEAD_DIM // 2
    return jnp.concatenate([rope_1d(x[..., :half], row_pos), rope_1d(x[..., half:], col_pos)], axis=-1)


def banded_attention(q, k, v, k_ctx, v_ctx, sink):
    bsz, s_len = q.shape[:2]
    nb = s_len // ATTN_BLOCK
    scale = HEAD_DIM ** -0.5
    qb = q.reshape(bsz, nb, ATTN_BLOCK, N_KV_HEADS, GQA_GROUP, HEAD_DIM)
    pad = ((0, 0), (ATTN_BLOCK, ATTN_BLOCK), (0, 0), (0, 0))

    def band(t):
        tp = jnp.pad(t, pad).reshape(bsz, nb + 2, ATTN_BLOCK, N_KV_HEADS, HEAD_DIM)
        return jnp.concatenate([tp[:, :-2], tp[:, 1:-1], tp[:, 2:]], axis=2)

    kb, vb = band(k), band(v)
    s_loc = jnp.einsum('bnqhgd,bnkhd->bnhgqk', qb, kb).astype(jnp.float32) * scale
    q_pos = jnp.arange(nb)[:, None] * ATTN_BLOCK + jnp.arange(ATTN_BLOCK)[None, :]
    k_pos = (jnp.arange(nb)[:, None] - 1) * ATTN_BLOCK + jnp.arange(3 * ATTN_BLOCK)[None, :]
    rel = k_pos[:, None, :] - q_pos[:, :, None]
    valid = (jnp.abs(rel) <= WINDOW) & (k_pos[:, None, :] >= 0) & (k_pos[:, None, :] < s_len)
    s_loc = jnp.where(valid[None, :, None, None], s_loc, NEG_INF)
    s_ctx = jnp.einsum('bnqhgd,bkhd->bnhgqk', qb, k_ctx).astype(jnp.float32) * scale
    s_sink = jnp.broadcast_to(sink[None, None, :, :, None, None], s_loc.shape[:-1] + (1,))
    p = jax.nn.softmax(jnp.concatenate([s_loc, s_ctx, s_sink], axis=-1), axis=-1).astype(v.dtype)
    n_loc = 3 * ATTN_BLOCK
    n_ctx = k_ctx.shape[1]
    o = (jnp.einsum('bnhgqk,bnkhd->bnqhgd', p[..., :n_loc], vb)
         + jnp.einsum('bnhgqk,bkhd->bnqhgd', p[..., n_loc:n_loc + n_ctx], v_ctx))
    return o.reshape(bsz, s_len, Q_WIDTH)


def context_attention(q, k, v, sink):
    s = jnp.einsum('bqhgd,bkhd->bhgqk', q, k).astype(jnp.float32) * HEAD_DIM ** -0.5
    s_sink = jnp.broadcast_to(sink[None, :, :, None, None], s.shape[:-1] + (1,))
    p = jax.nn.softmax(jnp.concatenate([s, s_sink], axis=-1), axis=-1).astype(v.dtype)
    o = jnp.einsum('bhgqk,bkhd->bqhgd', p[..., :-1], v)
    return o.reshape(q.shape[0], q.shape[1], Q_WIDTH)


def attn_mixer(h_lat, h_ctx, w_qkv, w_o, sink, row_pos, col_pos, need_ctx_out):
    bsz, s_len, _ = h_lat.shape
    n_ctx = h_ctx.shape[1]
    qkv = h_lat @ w_qkv
    q = axial_rope(qkv[..., :Q_WIDTH].reshape(bsz, s_len, N_Q_HEADS, HEAD_DIM), row_pos, col_pos)
    k = axial_rope(qkv[..., Q_WIDTH:Q_WIDTH + KV_WIDTH].reshape(bsz, s_len, N_KV_HEADS, HEAD_DIM), row_pos, col_pos)
    v = qkv[..., Q_WIDTH + KV_WIDTH:].reshape(bsz, s_len, N_KV_HEADS, HEAD_DIM)
    kv_ctx = h_ctx @ w_qkv[:, Q_WIDTH:]
    k_ctx = kv_ctx[..., :KV_WIDTH].reshape(bsz, n_ctx, N_KV_HEADS, HEAD_DIM)
    v_ctx = kv_ctx[..., KV_WIDTH:].reshape(bsz, n_ctx, N_KV_HEADS, HEAD_DIM)
    sink_logit = sink.astype(jnp.float32).reshape(N_KV_HEADS, GQA_GROUP)
    q = q.reshape(bsz, s_len, N_KV_HEADS, GQA_GROUP, HEAD_DIM)
    y_lat = banded_attention(q, k, v, k_ctx, v_ctx, sink_logit) @ w_o
    y_ctx = None
    if need_ctx_out:
        q_ctx = (h_ctx @ w_qkv[:, :Q_WIDTH]).reshape(bsz, n_ctx, N_KV_HEADS, GQA_GROUP, HEAD_DIM)
        y_ctx = context_attention(q_ctx, k_ctx, v_ctx, sink_logit) @ w_o
    return y_lat, y_ctx


def s5_discretise(lam_re, lam_im, log_dt, b_re, b_im):
    lam = lax.complex(lam_re.astype(jnp.float32), lam_im.astype(jnp.float32))
    dt = jnp.exp(log_dt.astype(jnp.float32))[:, None]
    lam_bar = jnp.exp(lam * dt)
    b = lax.complex(b_re.astype(jnp.float32), b_im.astype(jnp.float32))
    b_bar = ((lam_bar - 1.0) / lam)[..., None] * b
    return lam_bar, b_bar


def _linear_recurrence(e1, e2):
    a1, b1 = e1
    a2, b2 = e2
    return a1 * a2, a2 * b1 + b2


def s5_scan(u, lam_bar, b_bar, s0, reverse):
    bu = jnp.einsum('bngc,gpc->bngp', u.astype(jnp.complex64), b_bar)
    if s0 is not None:
        edge = u.shape[1] - 1 if reverse else 0
        bu = bu.at[:, edge].add(lam_bar[None] * s0)
    a = jnp.broadcast_to(lam_bar, (1, u.shape[1]) + lam_bar.shape)
    _, states = lax.associative_scan(_linear_recurrence, (a, bu), reverse=reverse, axis=1)
    return states


def ssm_mixer(h_lat, h_ctx, lam_re, lam_im, log_dt, b_re, b_im, c_re, c_im, d_skip, w_a, w_b, need_ctx_out):
    def groups(h):
        return h.astype(jnp.float32).reshape(h.shape[0], h.shape[1], SSM_N_GROUPS, SSM_GROUP)

    def readout(states, c_mat):
        y = jnp.real(jnp.einsum('bngp,gcp->bngc', states, c_mat))
        return y.reshape(states.shape[0], states.shape[1], D_MODEL)

    def glu(y, dtype):
        g = jax.nn.gelu(y).astype(dtype)
        return (g @ w_a) * jax.nn.sigmoid(g @ w_b)

    u_lat, u_ctx = groups(h_lat), groups(h_ctx)
    d32 = d_skip.astype(jnp.float32)
    y_lat = d32 * h_lat.astype(jnp.float32)
    y_ctx = d32 * h_ctx.astype(jnp.float32) if need_ctx_out else None
    for direction, reverse in enumerate((False, True)):
        lam_bar, b_bar = s5_discretise(lam_re[direction], lam_im[direction], log_dt[direction],
                                       b_re[direction], b_im[direction])
        c_mat = lax.complex(c_re[direction].astype(jnp.float32), c_im[direction].astype(jnp.float32))
        ctx_states = s5_scan(u_ctx, lam_bar, b_bar, None, reverse)
        ctx_final = ctx_states[:, 0] if reverse else ctx_states[:, -1]
        y_lat = y_lat + readout(s5_scan(u_lat, lam_bar, b_bar, ctx_final, reverse), c_mat)
        if need_ctx_out:
            y_ctx = y_ctx + readout(ctx_states, c_mat)
    out_ctx = glu(y_ctx, h_ctx.dtype) if need_ctx_out else None
    return glu(y_lat, h_lat.dtype), out_ctx


def gmlp_mixer(h, w_in, b_in, ln_g, ln_b, w_s, b_s, w_out):
    bsz, n, _ = h.shape
    z = jax.nn.gelu(h @ w_in + b_in)
    u = z[..., :GMLP_HALF]
    v = layer_norm(z[..., GMLP_HALF:], ln_g, ln_b)
    vc = v.reshape(bsz, n // GMLP_CHUNK, GMLP_CHUNK, GMLP_HEADS, GMLP_HEAD_DIM)
    gate = jnp.einsum('hpq,bnqhc->bnphc', w_s, vc) + b_s.T[None, None, :, :, None]
    return (u * gate.reshape(bsz, n, GMLP_HALF)) @ w_out


def conv_ffn(h, w_up, conv_w, conv_b, w_down):
    n = h.shape[1]
    a = h @ w_up
    pad = CONV_WIDTH // 2
    ap = jnp.pad(a, ((0, 0), (pad, pad), (0, 0)))
    a = conv_b + ap[:, 0:n] * conv_w[0]
    for tap in range(1, CONV_WIDTH):
        a = a + ap[:, tap:tap + n] * conv_w[tap]
    val, gate = a[..., :FFN_HIDDEN], a[..., FFN_HIDDEN:]
    return (val * jax.nn.silu(gate)) @ w_down


def _normal(key, shape, std):
    return std * jax.random.normal(key, shape, dtype=jnp.float32)


def _n_layers_of(kind):
    return len(range(MIXERS.index(kind), DEPTH, N_MIXERS))


def setup_inputs(seed: int = 0) -> dict:
    key = jax.random.key(seed)
    keys = iter(jax.random.split(key, 48))
    D = D_MODEL
    n_pool, n_attn, n_ssm, n_gmlp = (_n_layers_of(k) for k in MIXERS)
    qkv_width = Q_WIDTH + 2 * KV_WIDTH
    G, P = SSM_N_GROUPS, SSM_STATE
    return {
        'x': _normal(next(keys), (BATCH, SEQ, D), 1.0),
        'c': _normal(next(keys), (BATCH, D), 1.0),
        'ctx': _normal(next(keys), (BATCH, CTX_LEN, D), 1.0),
        'c_ctx': _normal(next(keys), (D,), 1.0),
        'ada_w': _normal(next(keys), (DEPTH, D, N_MODS * D), 0.5 * D ** -0.5),
        'ada_b': _normal(next(keys), (DEPTH, N_MODS * D), 0.02),
        'ln1_g': 1.0 + _normal(next(keys), (DEPTH, D), 0.02),
        'ln1_b': _normal(next(keys), (DEPTH, D), 0.02),
        'ln2_g': 1.0 + _normal(next(keys), (DEPTH, D), 0.02),
        'ln2_b': _normal(next(keys), (DEPTH, D), 0.02),
        'ffn_w_up': _normal(next(keys), (DEPTH, D, 2 * FFN_HIDDEN), D ** -0.5),
        'ffn_conv_w': _normal(next(keys), (DEPTH, CONV_WIDTH, 2 * FFN_HIDDEN), CONV_WIDTH ** -0.5),
        'ffn_conv_b': _normal(next(keys), (DEPTH, 2 * FFN_HIDDEN), 0.02),
        'ffn_w_down': _normal(next(keys), (DEPTH, FFN_HIDDEN, D), FFN_HIDDEN ** -0.5 * DEEPNORM_BETA),
        'pool_w': _normal(next(keys), (n_pool, N_POOL_GROUPS, POOL_GROUP, POOL_GROUP), POOL_GROUP ** -0.5 * DEEPNORM_BETA),
        'pool_b': _normal(next(keys), (n_pool, D), 0.02),
        'pool_scale': 1.0 + _normal(next(keys), (n_pool, D), 0.02),
        'attn_w_qkv': _normal(next(keys), (n_attn, D, qkv_width), D ** -0.5),
        'attn_w_o': _normal(next(keys), (n_attn, Q_WIDTH, D), Q_WIDTH ** -0.5 * DEEPNORM_BETA),
        'attn_sink': _normal(next(keys), (n_attn, N_Q_HEADS), 0.5),
        'ssm_lambda_re': -0.5 + _normal(next(keys), (n_ssm, 2, G, P), 1e-3),
        'ssm_lambda_im': jnp.pi * jnp.arange(P, dtype=jnp.float32) + _normal(next(keys), (n_ssm, 2, G, P), 1e-3),
        'ssm_log_dt': jax.random.uniform(next(keys), (n_ssm, 2, G), dtype=jnp.float32,
                                         minval=math.log(DT_MIN), maxval=math.log(DT_MAX)),
        'ssm_b_re': _normal(next(keys), (n_ssm, 2, G, P, SSM_GROUP), (2 * SSM_GROUP) ** -0.5),
        'ssm_b_im': _normal(next(keys), (n_ssm, 2, G, P, SSM_GROUP), (2 * SSM_GROUP) ** -0.5),
        'ssm_c_re': _normal(next(keys), (n_ssm, 2, G, SSM_GROUP, P), (2 * P) ** -0.5),
        'ssm_c_im': _normal(next(keys), (n_ssm, 2, G, SSM_GROUP, P), (2 * P) ** -0.5),
        'ssm_d': _normal(next(keys), (n_ssm, D), 1.0),
        'ssm_w_glu_a': _normal(next(keys), (n_ssm, D, D), D ** -0.5 * DEEPNORM_BETA),
        'ssm_w_glu_b': _normal(next(keys), (n_ssm, D, D), D ** -0.5),
        'gmlp_w_in': _normal(next(keys), (n_gmlp, D, 2 * GMLP_HALF), D ** -0.5),
        'gmlp_b_in': _normal(next(keys), (n_gmlp, 2 * GMLP_HALF), 0.02),
        'gmlp_ln_g': 1.0 + _normal(next(keys), (n_gmlp, GMLP_HALF), 0.02),
        'gmlp_ln_b': _normal(next(keys), (n_gmlp, GMLP_HALF), 0.02),
        'gmlp_w_s': _normal(next(keys), (n_gmlp, GMLP_HEADS, GMLP_CHUNK, GMLP_CHUNK), GMLP_CHUNK ** -0.5),
        'gmlp_b_s': 1.0 + _normal(next(keys), (n_gmlp, GMLP_HEADS, GMLP_CHUNK), 0.02),
        'gmlp_w_out': _normal(next(keys), (n_gmlp, GMLP_HALF, D), GMLP_HALF ** -0.5 * DEEPNORM_BETA),
    }


def reference(x, c, ctx, c_ctx, ada_w, ada_b, ln1_g, ln1_b, ln2_g, ln2_b,
              ffn_w_up, ffn_conv_w, ffn_conv_b, ffn_w_down,
              pool_w, pool_b, pool_scale,
              attn_w_qkv, attn_w_o, attn_sink,
              ssm_lambda_re, ssm_lambda_im, ssm_log_dt, ssm_b_re, ssm_b_im, ssm_c_re, ssm_c_im,
              ssm_d, ssm_w_glu_a, ssm_w_glu_b,
              gmlp_w_in, gmlp_b_in, gmlp_ln_g, gmlp_ln_b, gmlp_w_s, gmlp_b_s, gmlp_w_out):
    seq_len = x.shape[1]
    ROWS = seq_len // GRID_W
    row_pos = jnp.repeat(jnp.arange(ROWS), GRID_W)
    col_pos = jnp.tile(jnp.arange(GRID_W), ROWS)
    x_lat, x_ctx = x, ctx
    for layer in range(DEPTH):
        kind = MIXERS[layer % N_MIXERS]
        j = layer // N_MIXERS
        ctx_out = any(MIXERS[m % N_MIXERS] in CTX_READING_MIXERS for m in range(layer + 1, DEPTH))
        ctx_in = ctx_out or kind in CTX_READING_MIXERS
        sh1, sc1, gt1, sh2, sc2, gt2 = [m[:, None, :] for m in ada_modulations(c, ada_w[layer], ada_b[layer])]
        h_lat = modulate(x_lat, sh1, sc1)
        h_ctx = None
        if ctx_in:
            csh1, csc1, cgt1, csh2, csc2, cgt2 = ada_modulations(c_ctx, ada_w[layer], ada_b[layer])
            h_ctx = modulate(x_ctx, csh1, csc1)
        if kind == 'pool':
            y_lat = pool_mixer(h_lat, pool_w[j], pool_b[j], pool_scale[j])
            y_ctx = pool_mixer(h_ctx, pool_w[j], pool_b[j], pool_scale[j]) if ctx_out else None
        elif kind == 'attn':
            y_lat, y_ctx = attn_mixer(h_lat, h_ctx, attn_w_qkv[j], attn_w_o[j], attn_sink[j],
                                      row_pos, col_pos, ctx_out)
        elif kind == 'ssm':
            y_lat, y_ctx = ssm_mixer(h_lat, h_ctx, ssm_lambda_re[j], ssm_lambda_im[j], ssm_log_dt[j],
                                     ssm_b_re[j], ssm_b_im[j], ssm_c_re[j], ssm_c_im[j], ssm_d[j],
                                     ssm_w_glu_a[j], ssm_w_glu_b[j], ctx_out)
        else:
            y_lat = gmlp_mixer(h_lat, gmlp_w_in[j], gmlp_b_in[j], gmlp_ln_g[j], gmlp_ln_b[j],
                               gmlp_w_s[j], gmlp_b_s[j], gmlp_w_out[j])
            y_ctx = (gmlp_mixer(h_ctx, gmlp_w_in[j], gmlp_b_in[j], gmlp_ln_g[j], gmlp_ln_b[j],
                                gmlp_w_s[j], gmlp_b_s[j], gmlp_w_out[j]) if ctx_out else None)
        x_lat = post_norm_residual(x_lat, y_lat, gt1, ln1_g[layer], ln1_b[layer])
        f_lat = conv_ffn(modulate(x_lat, sh2, sc2), ffn_w_up[layer], ffn_conv_w[layer],
                         ffn_conv_b[layer], ffn_w_down[layer])
        x_lat = post_norm_residual(x_lat, f_lat, gt2, ln2_g[layer], ln2_b[layer])
        if ctx_out:
            x_ctx = post_norm_residual(x_ctx, y_ctx, cgt1, ln1_g[layer], ln1_b[layer])
            f_ctx = conv_ffn(modulate(x_ctx, csh2, csc2), ffn_w_up[layer], ffn_conv_w[layer],
                             ffn_conv_b[layer], ffn_w_down[layer])
            x_ctx = post_norm_residual(x_ctx, f_ctx, cgt2, ln2_g[layer], ln2_b[layer])
    return x_lat
```

```cpp
#include <hip/hip_runtime.h>
#include <hip/hip_cooperative_groups.h>
#include <cstdio>
namespace cg = cooperative_groups;

#define LAS __attribute__((address_space(3)))
typedef unsigned short bf16_t;
typedef short bf16x8 __attribute__((ext_vector_type(8)));
typedef float f32x4 __attribute__((ext_vector_type(4)));
typedef float f32x2 __attribute__((ext_vector_type(2)));
typedef unsigned u32x4 __attribute__((ext_vector_type(4)));
typedef unsigned u32x2 __attribute__((ext_vector_type(2)));

constexpr int D = 1024, TL = 16384, TA = 17408, SEQ = 4096, CTXL = 256, FH = 2816, F2 = 5632;
constexpr float ALPHA = 1.681792830507429f;
constexpr float LN_EPS = 1e-5f;
constexpr int MOD_SH1 = 0, MOD_SC1 = 1024, MOD_GT1 = 2048, MOD_SH2 = 3072, MOD_SC2 = 4096, MOD_GT2 = 5120;

constexpr size_t WS_MODS = 0;
constexpr size_t WS_ROPE = 512 * 1024;
constexpr size_t WS_LAML = WS_ROPE + 16 * 1024;
constexpr size_t WS_VSTAT = WS_LAML + 128 * 1024;
constexpr size_t WS_BAR = WS_VSTAT + 128 * 1024;
constexpr size_t WS_WUP = 1024 * 1024;
constexpr size_t WS_WDN = WS_WUP + (size_t)F2 * D * 2;
constexpr size_t WS_WPOOL = WS_WDN + (size_t)D * FH * 2;
constexpr size_t WS_WQKV = WS_WPOOL + (size_t)D * 256 * 2;
constexpr size_t WS_WO = WS_WQKV + (size_t)1536 * D * 2;
constexpr size_t WS_WGLU = WS_WO + (size_t)D * D * 2;
constexpr size_t WS_WGIN = WS_WGLU + (size_t)2048 * D * 2;
constexpr size_t WS_WGOUT = WS_WGIN + (size_t)4096 * D * 2;
constexpr size_t WS_WS16 = WS_WGOUT + (size_t)D * 2048 * 2;
constexpr size_t WS_KK = WS_WS16 + (size_t)8 * 128 * 128 * 2;
constexpr size_t WS_RESC = WS_KK + (size_t)64 * 128 * 256 * 2;
constexpr size_t WS_H = WS_RESC + (size_t)1024 * D * 4;
constexpr size_t WS_ABUF = WS_H + (size_t)TA * D * 2;
constexpr size_t WS_HID = WS_ABUF + (size_t)TA * F2 * 2;
constexpr size_t WS_LNSTAT = WS_HID + (size_t)TA * FH * 2;
constexpr size_t WS_LNCNT = WS_LNSTAT + (size_t)8 * TL * 2 * 4;
constexpr size_t WS_END = WS_LNCNT + (size_t)8 * 64 * 256;
constexpr size_t WS_QK = WS_ABUF;
constexpr size_t WS_VT = WS_ABUF + (size_t)TA * 1280 * 2;
constexpr size_t WS_ET = WS_ABUF;
constexpr size_t WS_GT = WS_ABUF + (size_t)2 * 64 * 128 * 1024 * 2;
constexpr size_t WS_SLOC = WS_HID;
constexpr size_t WS_SIN = WS_HID + (size_t)2 * 64 * 272 * 128 * 4;
constexpr size_t WS_GACT = WS_SIN + (size_t)2 * 64 * 272 * 128 * 2;
static_assert(WS_GACT + (size_t)TL * D * 2 <= WS_END, "ws map");

constexpr int LDS_BYTES = 163840;

__device__ __forceinline__ unsigned f2bf(float f) { typedef float f2s_t __attribute__((ext_vector_type(2))); typedef __bf16 b2s_t __attribute__((ext_vector_type(2))); f2s_t v = {f, 0.f}; b2s_t b = __builtin_convertvector(v, b2s_t); return __builtin_bit_cast(unsigned, b) & 0xffffu; }
__device__ __forceinline__ unsigned pk2(float lo, float hi) { typedef float f2_t __attribute__((ext_vector_type(2))); typedef __bf16 b2_t __attribute__((ext_vector_type(2))); f2_t v = {lo, hi}; b2_t b = __builtin_convertvector(v, b2_t); return __builtin_bit_cast(unsigned, b); }
__device__ __forceinline__ float bflo(unsigned w) { return __builtin_bit_cast(float, w << 16); }
__device__ __forceinline__ float bfhi(unsigned w) { return __builtin_bit_cast(float, w & 0xffff0000u); }
__device__ __forceinline__ float sigmoidf_(float x) { return __builtin_amdgcn_rcpf(1.0f + __expf(-x)); }
__device__ __forceinline__ float siluf_(float x) { return x * __builtin_amdgcn_rcpf(1.0f + __expf(-x)); }
__device__ __forceinline__ float gelu_tanh(float x) { const float u = 0.7978845608028654f * (x + 0.044715f * x * x * x); return x * __builtin_amdgcn_rcpf(1.0f + __expf(-2.0f * u)); }
__device__ __forceinline__ float wave_sum(float v) {
#pragma unroll
    for (int o = 1; o < 64; o <<= 1) v += __shfl_xor(v, o);
    return v;
}
#define LDS_WAIT() asm volatile("s_waitcnt lgkmcnt(0)" ::: "memory")
__device__ __forceinline__ f32x4 mfma16(bf16x8 a, bf16x8 b, f32x4 c) { return __builtin_amdgcn_mfma_f32_16x16x32_bf16(a, b, c, 0, 0, 0); }

namespace pg8 {
constexpr int BM = 256, BK = 64, HALF = 128, HTB = HALF * BK * 2, STAGE_BYTES = 8 * HTB, NXCD = 8, WGM = 8;
__host__ __device__ __forceinline__ int lds_byte(int r, int c) { const int st = (r >> 4) * 2 + (c >> 5), rr = r & 15, cc = c & 31, ob = rr * 64 + cc * 2; return st * 1024 + (ob ^ (((ob >> 9) & 1) << 5)); }
__host__ __device__ __forceinline__ void stage_rc(int b, int& R, int& C) { const int st = b / 1024, sb = b % 1024, swz = sb ^ (((sb >> 9) & 1) << 5); R = (st >> 1) * 16 + swz / 64; C = (st & 1) * 32 + (swz % 64) / 2; }
__host__ __device__ __forceinline__ int perm32(int rho) { const int n = rho >> 4, i = rho & 15; return 8 * (i >> 2) + 4 * n + (i & 3); }
struct Unit { int pm, pn; };
struct Gemm { const bf16_t* A; const bf16_t* Bt; int M, N, K, lda, ldb, apn, pshift, pmask, bpn; };
struct StaticOrder {
    int nM, nN, nwg, G, c, fixed_pm, fixed_pn;
    __device__ void init(int M, int N, int G_, int c_) { nM = M / BM; nN = N / BM; nwg = nM * nN; G = G_; c = c_; fixed_pm = -1; fixed_pn = 0; }
    __device__ bool next(int i, Unit& u) const {
        if (fixed_pm >= 0) { if (i > 0) return false; u.pm = fixed_pm; u.pn = fixed_pn; return true; }
        const long L = (long)i * G + c; if (L >= nwg) return false;
        int wgid = (int)L; { const int q = nwg / NXCD, r = nwg % NXCD, xcd = wgid % NXCD, off = wgid / NXCD; wgid = (xcd < r ? xcd * (q + 1) : r * (q + 1) + (xcd - r) * q) + off; }
        const int nig = WGM * nN, gid = wgid / nig, fm = gid * WGM, gsz = (nM - fm) < WGM ? (nM - fm) : WGM;
        u.pm = fm + ((wgid % nig) % gsz); u.pn = (wgid % nig) / gsz; return true;
    }
};
__device__ __forceinline__ unsigned cvt_pk_bf16(float lo, float hi) { unsigned r; asm volatile("v_cvt_pk_bf16_f32 %0, %1, %2" : "=v"(r) : "v"(lo), "v"(hi)); return r; }

template <class Epi>
__device__ __forceinline__ void gemm_phase(LAS unsigned char* lds, const Gemm g, const StaticOrder& S, const Epi& E, const int tid) {
    const int wid = __builtin_amdgcn_readfirstlane(tid >> 6), lane = tid & 63, wr = wid >> 2, wc = wid & 3, fr = lane & 15, fq = lane >> 4;
    const int K = g.K, nt = K / BK;
    unsigned voffA[2], voffB[2];
#pragma unroll
    for (int i = 0; i < 2; ++i) { int R, C; stage_rc(tid * 16 + i * 8192, R, C); const int Rb = Epi::PERM ? ((R & ~31) + perm32(R & 31)) : R;
        voffA[i] = (unsigned)(R * g.lda + C) * 2u; voffB[i] = (unsigned)(Rb * g.ldb + C) * 2u; }
    const size_t kstep = (size_t)(BK * 2);
    const size_t hstepA = (size_t)HALF * g.lda * 2, hstepB = (size_t)HALF * g.ldb * 2;
    const unsigned ldsw = (unsigned)wid * 1024u;
    const int aoff = lds_byte(wr * 64 + fr, fq * 8), boff = lds_byte(wc * 32 + fr, fq * 8);
#define PG8_SA(b, h) (((b) * 2 + (h)) * HTB)
#define PG8_SB(b, h) ((4 + (b) * 2 + (h)) * HTB)
#define PG8_STAGE(bufoff, gbase, voff) do { _Pragma("unroll") for (int _i = 0; _i < 2; ++_i) \
        __builtin_amdgcn_global_load_lds((const unsigned*)((const char*)(gbase) + (voff)[_i]), (LAS unsigned*)(lds + (bufoff) + ldsw + _i * 8192), 16, 0, 0); } while (0)
#define PG8_LDA(dst, b, h) do { _Pragma("unroll") for (int m = 0; m < 4; ++m) _Pragma("unroll") for (int k = 0; k < 2; ++k) dst[m][k] = *(const LAS bf16x8*)(lds + PG8_SA(b, h) + aoff + m * 2048 + k * 1024); } while (0)
#define PG8_LDB(dst, b, h) do { _Pragma("unroll") for (int n = 0; n < 2; ++n) _Pragma("unroll") for (int k = 0; k < 2; ++k) dst[n][k] = *(const LAS bf16x8*)(lds + PG8_SB(b, h) + boff + n * 2048 + k * 1024); } while (0)
#define PG8_MMA(ai, bj, At, Bt) do { __builtin_amdgcn_s_setprio(1); _Pragma("unroll") for (int m = 0; m < 4; ++m) _Pragma("unroll") for (int n = 0; n < 2; ++n) _Pragma("unroll") for (int k = 0; k < 2; ++k) \
        acc[ai][bj][m][n] = __builtin_amdgcn_mfma_f32_16x16x32_bf16(Bt[n][k], At[m][k], acc[ai][bj][m][n], 0, 0, 0); __builtin_amdgcn_s_setprio(0); } while (0)
#define PG8_WAIT_V(n) asm volatile("s_waitcnt vmcnt(" #n ")" ::: "memory")
#define PG8_WAIT_L(n) asm volatile("s_waitcnt lgkmcnt(" #n ")" ::: "memory")
#define PG8_BAR __builtin_amdgcn_s_barrier()
#define PG8_SCHED __builtin_amdgcn_sched_barrier(0)
    Unit cur, nxt; int ui = 0;
    if (!S.next(0, cur)) return;
    f32x4 acc[2][2][4][2];
#pragma unroll
    for (int a = 0; a < 2; ++a)
#pragma unroll
        for (int b = 0; b < 2; ++b)
#pragma unroll
            for (int m = 0; m < 4; ++m)
#pragma unroll
                for (int n = 0; n < 2; ++n) acc[a][b][m][n] = (f32x4){0.f, 0.f, 0.f, 0.f};
    bf16x8 At[4][2], B0[2][2], B1[2][2];
    const char* cA = (const char*)g.A + (size_t)cur.pm * 2 * hstepA + (size_t)(cur.pn >> g.pshift) * g.apn * 2; const char* cB = (const char*)g.Bt + (size_t)(cur.pn & g.pmask) * 2 * hstepB + (size_t)(cur.pn >> g.pshift) * g.bpn * 2;
    PG8_STAGE(PG8_SB(0, 0), cB, voffB); PG8_STAGE(PG8_SA(0, 0), cA, voffA); PG8_STAGE(PG8_SB(0, 1), cB + hstepB, voffB); PG8_STAGE(PG8_SA(0, 1), cA + hstepA, voffA);
    if (wr == 1) PG8_BAR;
    PG8_WAIT_V(4); PG8_BAR;
    PG8_STAGE(PG8_SB(1, 0), cB + kstep, voffB); PG8_STAGE(PG8_SA(1, 0), cA + kstep, voffA); PG8_STAGE(PG8_SB(1, 1), cB + hstepB + kstep, voffB);
    PG8_WAIT_V(6); PG8_BAR;
    for (;;) {
        const bool has_next = S.next(ui + 1, nxt);
        const char* nA = has_next ? (const char*)g.A + (size_t)nxt.pm * 2 * hstepA + (size_t)(nxt.pn >> g.pshift) * g.apn * 2 : cA; const char* nB = has_next ? (const char*)g.Bt + (size_t)(nxt.pn & g.pmask) * 2 * hstepB + (size_t)(nxt.pn >> g.pshift) * g.bpn * 2 : cB;
        for (int t = 0; t < nt; t += 2) {
            const bool last = (t == nt - 2);
            const char* a1 = cA + (size_t)(t + 1) * kstep;
            const char* a2 = last ? nA : cA + (size_t)(t + 2) * kstep; const char* b2 = last ? nB : cB + (size_t)(t + 2) * kstep;
            const char* a3 = a2 + kstep; const char* b3 = b2 + kstep;
            PG8_LDB(B0, 0, 0); PG8_SCHED; PG8_LDA(At, 0, 0); PG8_STAGE(PG8_SA(1, 1), a1 + hstepA, voffA);
            PG8_WAIT_L(8); PG8_BAR; PG8_WAIT_L(0); PG8_MMA(0, 0, At, B0); PG8_BAR; PG8_SCHED;
            PG8_LDB(B1, 0, 1); PG8_STAGE(PG8_SB(0, 0), b2, voffB);
            PG8_BAR; PG8_WAIT_L(0); PG8_MMA(0, 1, At, B1); PG8_BAR;
            PG8_LDA(At, 0, 1); PG8_STAGE(PG8_SA(0, 0), a2, voffA);
            PG8_BAR; PG8_WAIT_L(0); PG8_MMA(1, 0, At, B0); PG8_BAR; PG8_SCHED;
            PG8_STAGE(PG8_SB(0, 1), b2 + hstepB, voffB);
            PG8_WAIT_V(6); PG8_BAR; PG8_MMA(1, 1, At, B1); PG8_BAR;
            PG8_LDB(B0, 1, 0); PG8_SCHED; PG8_LDA(At, 1, 0); PG8_STAGE(PG8_SA(0, 1), a2 + hstepA, voffA);
            PG8_WAIT_L(8); PG8_BAR; PG8_WAIT_L(0); PG8_MMA(0, 0, At, B0); PG8_BAR; PG8_SCHED;
            PG8_LDB(B1, 1, 1); PG8_STAGE(PG8_SB(1, 0), b3, voffB);
            PG8_BAR; PG8_WAIT_L(0); PG8_MMA(0, 1, At, B1); PG8_BAR;
            PG8_LDA(At, 1, 1); PG8_STAGE(PG8_SA(1, 0), a3, voffA);
            PG8_BAR; PG8_WAIT_L(0); PG8_MMA(1, 0, At, B0); PG8_BAR; PG8_SCHED;
            PG8_STAGE(PG8_SB(1, 1), b3 + hstepB, voffB);
            PG8_WAIT_V(6); PG8_BAR; PG8_MMA(1, 1, At, B1); PG8_BAR;
        }
        if constexpr (!Epi::AFTER_DRAIN) E(acc, cur, wr, wc, fr, fq);
        if (!has_next) break;
#pragma unroll
        for (int a = 0; a < 2; ++a)
#pragma unroll
            for (int b = 0; b < 2; ++b)
#pragma unroll
                for (int m = 0; m < 4; ++m)
#pragma unroll
                    for (int n = 0; n < 2; ++n) acc[a][b][m][n] = (f32x4){0.f, 0.f, 0.f, 0.f};
        cur = nxt; cA = nA; cB = nB; ++ui;
    }
    PG8_WAIT_V(0);
    if (wr == 0) PG8_BAR;
    PG8_BAR;
    if constexpr (Epi::AFTER_DRAIN) E.fused(acc, cur, wr, wc, fr, fq, lds, tid);
#undef PG8_SA
#undef PG8_SB
#undef PG8_STAGE
#undef PG8_LDA
#undef PG8_LDB
#undef PG8_MMA
#undef PG8_WAIT_V
#undef PG8_WAIT_L
#undef PG8_BAR
#undef PG8_SCHED
}
}

template <int ACT  > struct EpiBf16 {
    static constexpr bool PERM = true, AFTER_DRAIN = false;
    bf16_t* O; int ldc; const float* bias; float* stat;
    __device__ __forceinline__ void operator()(const f32x4 (&acc)[2][2][4][2], const pg8::Unit& u, int wr, int wc, int fr, int fq) const {
        asm volatile("" : "+v"(fr), "+v"(fq));
        const int row0 = u.pm * 256 + wr * 64 + fr, col0 = u.pn * 256 + wc * 32 + 8 * fq;
#pragma unroll
        for (int ai = 0; ai < 2; ++ai)
#pragma unroll
            for (int m = 0; m < 4; ++m) { bf16_t* rowp = O + (size_t)(row0 + ai * 128 + m * 16) * ldc + col0;
                float ssum = 0.f, ssq = 0.f;
#pragma unroll
                for (int bj = 0; bj < 2; ++bj) { f32x4 v0 = acc[ai][bj][m][0], v1 = acc[ai][bj][m][1];
                    if (ACT >= 1) { const f32x4 b0 = *(const f32x4*)(bias + col0 + bj * 128), b1 = *(const f32x4*)(bias + col0 + bj * 128 + 4);
#pragma unroll
                        for (int j = 0; j < 4; ++j) { v0[j] = gelu_tanh(v0[j] + b0[j]); v1[j] = gelu_tanh(v1[j] + b1[j]); } }
                    u32x4 w; w.x = pg8::cvt_pk_bf16(v0[0], v0[1]); w.y = pg8::cvt_pk_bf16(v0[2], v0[3]); w.z = pg8::cvt_pk_bf16(v1[0], v1[1]); w.w = pg8::cvt_pk_bf16(v1[2], v1[3]);
                    if (ACT == 2) {
#pragma unroll
                        for (int j = 0; j < 4; ++j) { ssum += v0[j] + v1[j]; ssq += v0[j] * v0[j] + v1[j] * v1[j]; } }
                    *(u32x4*)(rowp + bj * 128) = w; }
                if (ACT == 2 && u.pn >= 8) { ssum += __shfl_xor(ssum, 16); ssum += __shfl_xor(ssum, 32); ssq += __shfl_xor(ssq, 16); ssq += __shfl_xor(ssq, 32);
                    if (fq == 0) { float* sp = stat + 2 * (size_t)(row0 + ai * 128 + m * 16);
                        (void)__hip_atomic_fetch_add(sp, ssum, __ATOMIC_RELAXED, __HIP_MEMORY_SCOPE_AGENT); (void)__hip_atomic_fetch_add(sp + 1, ssq, __ATOMIC_RELAXED, __HIP_MEMORY_SCOPE_AGENT); } } }
    }
};
template <int GLU> struct EpiRes {
    static constexpr bool PERM = false, AFTER_DRAIN = false;
    const float* xin_lat; const float* xin_ctx; float* out_lat; float* out_ctx; const float* mods; int gate_off; const float* bias; const float* scale; int row_base;
    __device__ __forceinline__ void operator()(const f32x4 (&acc)[2][2][4][2], const pg8::Unit& u, int wr, int wc, int fr, int fq) const {
        asm volatile("" : "+v"(fr), "+v"(fq));
        const int rowt = u.pm * 256 + row_base; const bool isctx = rowt >= TL; const int cond = isctx ? 4 : (rowt >> 12);
        const float* gate = mods + cond * 6144 + gate_off;
        const float* xi = isctx ? xin_ctx + (size_t)(rowt - TL) * D : xin_lat + (size_t)rowt * D;
        float* xo = isctx ? out_ctx + (size_t)(rowt - TL) * D : out_lat + (size_t)rowt * D;
        const int rl0 = wr * 64 + fr;
        if (GLU) {
            const int col0 = u.pn * 128 + wc * 32 + 4 * fq;
#pragma unroll
            for (int n = 0; n < 2; ++n) { const f32x4 g4 = *(const f32x4*)(gate + col0 + n * 16);
                f32x4 xv[8];
#pragma unroll
                for (int q = 0; q < 8; ++q) xv[q] = *(const f32x4*)(xi + (size_t)(rl0 + (q >> 2) * 128 + (q & 3) * 16) * D + col0 + n * 16);
#pragma unroll
                for (int q = 0; q < 8; ++q) { const int ai = q >> 2, m = q & 3; const size_t o = (size_t)(rl0 + ai * 128 + m * 16) * D + col0 + n * 16;
                    const f32x4 a = acc[ai][0][m][n], b = acc[ai][1][m][n]; f32x4 v;
#pragma unroll
                    for (int j = 0; j < 4; ++j) v[j] = ALPHA * xv[q][j] + g4[j] * (a[j] * sigmoidf_(b[j]));
                    *(f32x4*)(xo + o) = v; } }
        } else {
            const int col0 = u.pn * 256 + wc * 32 + 4 * fq;
#pragma unroll
            for (int bj = 0; bj < 2; ++bj)
#pragma unroll
                for (int n = 0; n < 2; ++n) { const int c = col0 + bj * 128 + n * 16; const f32x4 g4 = *(const f32x4*)(gate + c);
                    f32x4 b4 = (f32x4){0.f, 0.f, 0.f, 0.f}, s4 = (f32x4){1.f, 1.f, 1.f, 1.f};
                    if (bias) { b4 = *(const f32x4*)(bias + c); s4 = *(const f32x4*)(scale + c); }
#pragma unroll
                    for (int hb = 0; hb < 2; ++hb) {
                        f32x4 xv[4];
#pragma unroll
                        for (int q = 0; q < 4; ++q) xv[q] = *(const f32x4*)(xi + (unsigned)(rl0 + hb * 128 + q * 16) * (unsigned)D + (unsigned)c);
                        __builtin_amdgcn_sched_barrier(0);
#pragma unroll
                        for (int q = 0; q < 4; ++q) { const f32x4 a = acc[hb][bj][q][n]; f32x4 v;
#pragma unroll
                            for (int j = 0; j < 4; ++j) v[j] = ALPHA * xv[q][j] + g4[j] * ((a[j] + b4[j]) * s4[j]);
                            *(f32x4*)(xo + (unsigned)(rl0 + hb * 128 + q * 16) * (unsigned)D + (unsigned)c) = v; }
                        asm volatile("" ::: "memory"); __builtin_amdgcn_sched_barrier(0); } }
        }
    }
};
struct EpiResLn {
    static constexpr bool PERM = false, AFTER_DRAIN = true;
    float* res; const float* mods; int gate_off; const float* lng; const float* lnb; bf16_t* Hout; const float* hmods; int sh_off, sc_off; float* stat; unsigned* cnt;
    int hgm;
    const float* xin; const float* bias; const float* scale;
    __device__ __forceinline__ void prefetch(const pg8::Unit& u, int tid, int wid, LAS unsigned char* lds) const {
        const int upm = __builtin_amdgcn_readfirstlane(u.pm), upn = __builtin_amdgcn_readfirstlane(u.pn);
        const float* base = xin + (size_t)upm * 256 * D + upn * 256;
#pragma unroll
        for (int k = 0; k < 4; ++k) { const int q = tid + 512 * k;
            __builtin_amdgcn_global_load_lds((const unsigned*)(base + (size_t)(q >> 3) * D + (q & 7) * 32), (LAS unsigned*)(lds + 157696 + wid * 256), 4, 0, 0); }
    }
    __device__ __forceinline__ void operator()(const f32x4 (&)[2][2][4][2], const pg8::Unit&, int, int, int, int) const {}
    __device__ __forceinline__ void fused(f32x4 (&acc)[2][2][4][2], const pg8::Unit& u, int wr, int wc, int fr, int fq, LAS unsigned char* lds, int tid) const {
        const int upm = __builtin_amdgcn_readfirstlane(u.pm), upn = __builtin_amdgcn_readfirstlane(u.pn);
        const int rowt = upm * 256, cond = rowt >> 12;
        const float* gate = mods + cond * 6144 + gate_off;
        float* xo = res + (size_t)rowt * D; bf16_t* ho = Hout + (size_t)rowt * D; const float* xi = xin + (size_t)rowt * D;
        const int rl0 = wr * 64 + fr, col0 = upn * 256 + wc * 32 + 4 * fq;
        LAS f32x2* P = (LAS f32x2*)lds;
        LAS f32x2* S = (LAS f32x2*)(lds + 8192);
#pragma unroll
        for (int bj = 0; bj < 2; ++bj)
#pragma unroll
            for (int n = 0; n < 2; ++n) { const int c = col0 + bj * 128 + n * 16; const f32x4 g4 = *(const f32x4*)(gate + c);
                f32x4 b4 = (f32x4){0.f, 0.f, 0.f, 0.f}, s4 = (f32x4){1.f, 1.f, 1.f, 1.f};
                if (bias) { b4 = *(const f32x4*)(bias + c); s4 = *(const f32x4*)(scale + c); }
#pragma unroll
                for (int hb = 0; hb < 2; ++hb) {
                    f32x4 xv[4];
#pragma unroll
                    for (int q = 0; q < 4; ++q) { const unsigned o = (unsigned)(rl0 + hb * 128 + q * 16) * (unsigned)D + (unsigned)c; xv[q] = *(const f32x4*)(xi + o); }
                    __builtin_amdgcn_sched_barrier(0);
#pragma unroll
                    for (int q = 0; q < 4; ++q) { acc[hb][bj][q][n] = ALPHA * xv[q] + g4 * ((acc[hb][bj][q][n] + b4) * s4); asm volatile("" : "+v"(acc[hb][bj][q][n])); }
                    asm volatile("" ::: "memory"); __builtin_amdgcn_sched_barrier(0); } }
#pragma unroll
        for (int ai = 0; ai < 2; ++ai)
#pragma unroll
            for (int m = 0; m < 4; ++m) { float s = 0.f, q = 0.f;
#pragma unroll
                for (int bj = 0; bj < 2; ++bj)
#pragma unroll
                    for (int n = 0; n < 2; ++n) { const f32x4 x = acc[ai][bj][m][n]; s += (x[0] + x[1]) + (x[2] + x[3]); q += (x[0] * x[0] + x[1] * x[1]) + (x[2] * x[2] + x[3] * x[3]); }
                s += __shfl_xor(s, 16); s += __shfl_xor(s, 32); q += __shfl_xor(q, 16); q += __shfl_xor(q, 32);
                if (fq == 0) P[(ai * 128 + wr * 64 + m * 16 + fr) * 4 + wc] = (f32x2){s, q}; }
        LDS_WAIT(); __syncthreads();
        if (tid < 256) { const f32x2 a = P[tid * 4 + 0], b = P[tid * 4 + 1], c2 = P[tid * 4 + 2], d = P[tid * 4 + 3];
            float* sp = stat + 2 * (size_t)(rowt + tid);
            const float r0 = __hip_atomic_fetch_add(sp, (a.x + b.x) + (c2.x + d.x), __ATOMIC_RELAXED, __HIP_MEMORY_SCOPE_AGENT);
            const float r1 = __hip_atomic_fetch_add(sp + 1, (a.y + b.y) + (c2.y + d.y), __ATOMIC_RELAXED, __HIP_MEMORY_SCOPE_AGENT);
            asm volatile("" :: "v"(r0), "v"(r1)); }
        asm volatile("s_waitcnt vmcnt(0)" ::: "memory");
        __syncthreads();
        if (tid == 0) { unsigned* cp = cnt + 64 * upm;
            (void)__hip_atomic_fetch_add(cp, 1u, __ATOMIC_RELAXED, __HIP_MEMORY_SCOPE_AGENT);
            unsigned sp_ = 0;
            while (__hip_atomic_load(cp, __ATOMIC_RELAXED, __HIP_MEMORY_SCOPE_AGENT) < 4u) { __builtin_amdgcn_s_sleep(2); if (++sp_ > (1u << 22)) break; } }
        __syncthreads();
        if (tid < 256) { const float* sp = stat + 2 * (size_t)(rowt + tid);
            const float s = __hip_atomic_load(sp, __ATOMIC_RELAXED, __HIP_MEMORY_SCOPE_AGENT), q = __hip_atomic_load(sp + 1, __ATOMIC_RELAXED, __HIP_MEMORY_SCOPE_AGENT);
            const float mean = s * (1.f / D), var = fmaxf(q * (1.f / D) - mean * mean, 0.f);
            S[tid] = (f32x2){mean, __builtin_amdgcn_rsqf(var + LN_EPS)}; }
        LDS_WAIT(); __syncthreads();
#pragma unroll
        for (int bj = 0; bj < 2; ++bj)
#pragma unroll
            for (int n = 0; n < 2; ++n) { const int c = col0 + bj * 128 + n * 16; const f32x4 lg4 = *(const f32x4*)(lng + c), lb4 = *(const f32x4*)(lnb + c);
                f32x4 sh4 = (f32x4){0.f, 0.f, 0.f, 0.f}, sc4 = sh4;
                if (Hout) { sh4 = *(const f32x4*)(hmods + cond * 6144 + sh_off + c); sc4 = 1.0f + *(const f32x4*)(hmods + cond * 6144 + sc_off + c); }
#pragma unroll
                for (int q = 0; q < 8; ++q) { const int ai = q >> 2, m = q & 3; const unsigned o = (unsigned)(rl0 + ai * 128 + m * 16) * (unsigned)D + (unsigned)c;
                    const f32x2 stq = S[ai * 128 + wr * 64 + m * 16 + fr];
                    const f32x4 x = (acc[ai][bj][m][n] - stq.x) * stq.y * lg4 + lb4;
                    *(f32x4*)(xo + o) = x;
                    if (Hout) { const f32x4 h = x * sc4 + sh4; u32x2 w; w.x = pk2(h[0], h[1]); w.y = pk2(h[2], h[3]);
                        if (hgm) *(u32x2*)(Hout + ((size_t)(c >> 4) * TA + rowt + rl0 + ai * 128 + m * 16) * 16 + (c & 15)) = w; else *(u32x2*)(ho + o) = w; } }
                asm volatile("" ::: "memory"); __builtin_amdgcn_sched_barrier(0); }
        LDS_WAIT(); __syncthreads();
    }
};
struct EpiGluLn {
    static constexpr bool PERM = false, AFTER_DRAIN = true;
    float* res; const float* mods; int gate_off; const float* lng; const float* lnb; bf16_t* Hout; const float* hmods; int sh_off, sc_off; float* stat; unsigned* cnt;
    __device__ __forceinline__ void prefetch(const pg8::Unit& u, int tid, int wid, LAS unsigned char* lds) const {
        const int upm = __builtin_amdgcn_readfirstlane(u.pm), upn = __builtin_amdgcn_readfirstlane(u.pn);
        const float* base = res + (size_t)upm * 256 * D + upn * 128;
#pragma unroll
        for (int k = 0; k < 2; ++k) { const int q = tid + 512 * k;
            __builtin_amdgcn_global_load_lds((const unsigned*)(base + (size_t)(q >> 2) * D + (q & 3) * 32), (LAS unsigned*)(lds + 157696 + wid * 256), 4, 0, 0); }
    }
    __device__ __forceinline__ void operator()(const f32x4 (&)[2][2][4][2], const pg8::Unit&, int, int, int, int) const {}
    __device__ __forceinline__ void fused(f32x4 (&acc)[2][2][4][2], const pg8::Unit& u, int wr, int wc, int fr, int fq, LAS unsigned char* lds, int tid) const {
        const int upm = __builtin_amdgcn_readfirstlane(u.pm), upn = __builtin_amdgcn_readfirstlane(u.pn);
        const int rowt = upm * 256, cond = rowt >> 12;
        const float* gate = mods + cond * 6144 + gate_off;
        float* xo = res + (size_t)rowt * D; bf16_t* ho = Hout + (size_t)rowt * D;
        const int rl0 = wr * 64 + fr, col0 = upn * 128 + wc * 32 + 4 * fq;
        LAS f32x2* P = (LAS f32x2*)lds; LAS f32x2* S = (LAS f32x2*)(lds + 8192);
#pragma unroll
        for (int n = 0; n < 2; ++n) { const int c = col0 + n * 16; const f32x4 g4 = *(const f32x4*)(gate + c);
#pragma unroll
            for (int hb = 0; hb < 2; ++hb) {
                f32x4 xv[4];
#pragma unroll
                for (int q = 0; q < 4; ++q) { const unsigned o = (unsigned)(rl0 + hb * 128 + q * 16) * (unsigned)D + (unsigned)c; xv[q] = *(const f32x4*)(xo + o); }
                __builtin_amdgcn_sched_barrier(0);
#pragma unroll
                for (int q = 0; q < 4; ++q) { const f32x4 a = acc[hb][0][q][n], b = acc[hb][1][q][n]; f32x4 v;
#pragma unroll
                    for (int j = 0; j < 4; ++j) v[j] = ALPHA * xv[q][j] + g4[j] * (a[j] * sigmoidf_(b[j]));
                    acc[hb][0][q][n] = v; asm volatile("" : "+v"(acc[hb][0][q][n])); }
                asm volatile("" ::: "memory"); __builtin_amdgcn_sched_barrier(0); } }
#pragma unroll
        for (int ai = 0; ai < 2; ++ai)
#pragma unroll
            for (int m = 0; m < 4; ++m) { float s = 0.f, q = 0.f;
#pragma unroll
                for (int n = 0; n < 2; ++n) { const f32x4 x = acc[ai][0][m][n]; s += (x[0] + x[1]) + (x[2] + x[3]); q += (x[0] * x[0] + x[1] * x[1]) + (x[2] * x[2] + x[3] * x[3]); }
                s += __shfl_xor(s, 16); s += __shfl_xor(s, 32); q += __shfl_xor(q, 16); q += __shfl_xor(q, 32);
                if (fq == 0) P[(ai * 128 + wr * 64 + m * 16 + fr) * 4 + wc] = (f32x2){s, q}; }
        LDS_WAIT(); __syncthreads();
        if (tid < 256) { const f32x2 a = P[tid * 4 + 0], b = P[tid * 4 + 1], c2 = P[tid * 4 + 2], d = P[tid * 4 + 3];
            float* sp = stat + 2 * (size_t)(rowt + tid);
            const float r0 = __hip_atomic_fetch_add(sp, (a.x + b.x) + (c2.x + d.x), __ATOMIC_RELAXED, __HIP_MEMORY_SCOPE_AGENT);
            const float r1 = __hip_atomic_fetch_add(sp + 1, (a.y + b.y) + (c2.y + d.y), __ATOMIC_RELAXED, __HIP_MEMORY_SCOPE_AGENT);
            asm volatile("" :: "v"(r0), "v"(r1)); }
        asm volatile("s_waitcnt vmcnt(0)" ::: "memory");
        __syncthreads();
        if (tid == 0) { unsigned* cp = cnt + 64 * upm;
            (void)__hip_atomic_fetch_add(cp, 1u, __ATOMIC_RELAXED, __HIP_MEMORY_SCOPE_AGENT);
            unsigned sp_ = 0;
            while (__hip_atomic_load(cp, __ATOMIC_RELAXED, __HIP_MEMORY_SCOPE_AGENT) < 8u) { __builtin_amdgcn_s_sleep(2); if (++sp_ > (1u << 22)) break; } }
        __syncthreads();
        if (tid < 256) { const float* sp = stat + 2 * (size_t)(rowt + tid);
            const float s = __hip_atomic_load(sp, __ATOMIC_RELAXED, __HIP_MEMORY_SCOPE_AGENT), q = __hip_atomic_load(sp + 1, __ATOMIC_RELAXED, __HIP_MEMORY_SCOPE_AGENT);
            const float mean = s * (1.f / D), var = fmaxf(q * (1.f / D) - mean * mean, 0.f);
            S[tid] = (f32x2){mean, __builtin_amdgcn_rsqf(var + LN_EPS)}; }
        LDS_WAIT(); __syncthreads();
#pragma unroll
        for (int n = 0; n < 2; ++n) { const int c = col0 + n * 16; const f32x4 lg4 = *(const f32x4*)(lng + c), lb4 = *(const f32x4*)(lnb + c);
            const f32x4 sh4 = *(const f32x4*)(hmods + cond * 6144 + sh_off + c), sc4 = 1.0f + *(const f32x4*)(hmods + cond * 6144 + sc_off + c);
#pragma unroll
            for (int q = 0; q < 8; ++q) { const int ai = q >> 2, m = q & 3; const unsigned o = (unsigned)(rl0 + ai * 128 + m * 16) * (unsigned)D + (unsigned)c;
                const f32x2 stq = S[ai * 128 + wr * 64 + m * 16 + fr];
                const f32x4 x = (acc[ai][0][m][n] - stq.x) * stq.y * lg4 + lb4;
                *(f32x4*)(xo + o) = x;
                const f32x4 h = x * sc4 + sh4; u32x2 w; w.x = pk2(h[0], h[1]); w.y = pk2(h[2], h[3]); *(u32x2*)(ho + o) = w; }
            asm volatile("" ::: "memory"); __builtin_amdgcn_sched_barrier(0); }
        LDS_WAIT(); __syncthreads();
    }
};
struct EpiAtomic {
    static constexpr bool PERM = false, AFTER_DRAIN = false;
    float* part;
    __device__ __forceinline__ void operator()(const f32x4 (&acc)[2][2][4][2], const pg8::Unit& u, int wr, int wc, int fr, int fq) const {
        asm volatile("" : "+v"(fr), "+v"(fq));
        const int row0 = u.pm * 256 + wr * 64 + fr, col0 = (u.pn & 3) * 256 + wc * 32 + 4 * fq;
        float* base = part + (size_t)(u.pn >> 2) * 1024 * 1024;
#pragma unroll
        for (int ai = 0; ai < 2; ++ai)
#pragma unroll
            for (int m = 0; m < 4; ++m) { float* o = base + (size_t)(row0 + ai * 128 + m * 16) * D + col0;
#pragma unroll
                for (int bj = 0; bj < 2; ++bj)
#pragma unroll
                    for (int n = 0; n < 2; ++n) *(f32x4*)(o + bj * 128 + n * 16) = acc[ai][bj][m][n]; }
    }
};
struct EpiRope {
    static constexpr bool PERM = false, AFTER_DRAIN = false;
    bf16_t* QK; bf16_t* VT; const float* rope;
    __device__ __forceinline__ void operator()(const f32x4 (&acc)[2][2][4][2], const pg8::Unit& u, int wr, int wc, int fr, int fq) const {
        asm volatile("" : "+v"(fr), "+v"(fq));
        const int rowt = u.pm * 256; const bool isctx = rowt >= TL;
        const int rl0 = rowt + wr * 64 + fr;
        if (u.pn < 5) {
            const int colb = u.pn * 256 + wc * 32 + 4 * fq;
#pragma unroll
            for (int ai = 0; ai < 2; ++ai)
#pragma unroll
                for (int m = 0; m < 4; ++m) { const int r = rl0 + ai * 128 + m * 16; const int t = r & 4095; const int pos = (wc & 1) ? (t & 63) : (t >> 6);
                    f32x4 cs0 = (f32x4){1.f, 0.f, 1.f, 0.f}, cs1 = cs0;
                    if (!isctx) { cs0 = *(const f32x4*)(rope + (pos * 16 + 4 * fq) * 2); cs1 = *(const f32x4*)(rope + (pos * 16 + 4 * fq + 2) * 2); }
#pragma unroll
                    for (int bj = 0; bj < 2; ++bj) { const f32x4 x1 = acc[ai][bj][m][0], x2 = acc[ai][bj][m][1];
                        f32x4 o1, o2;
                        o1[0] = x1[0] * cs0[0] - x2[0] * cs0[1]; o2[0] = x1[0] * cs0[1] + x2[0] * cs0[0];
                        o1[1] = x1[1] * cs0[2] - x2[1] * cs0[3]; o2[1] = x1[1] * cs0[3] + x2[1] * cs0[2];
                        o1[2] = x1[2] * cs1[0] - x2[2] * cs1[1]; o2[2] = x1[2] * cs1[1] + x2[2] * cs1[0];
                        o1[3] = x1[3] * cs1[2] - x2[3] * cs1[3]; o2[3] = x1[3] * cs1[3] + x2[3] * cs1[2];
                        bf16_t* p = QK + (size_t)r * 1280 + colb + bj * 128;
                        u32x2 w1, w2; w1.x = pk2(o1[0], o1[1]); w1.y = pk2(o1[2], o1[3]); w2.x = pk2(o2[0], o2[1]); w2.y = pk2(o2[2], o2[3]);
                        *(u32x2*)p = w1; *(u32x2*)(p + 16) = w2; } }
        } else {
            const int colb = wc * 32 + 4 * fq;
#pragma unroll
            for (int ai = 0; ai < 2; ++ai)
#pragma unroll
                for (int m = 0; m < 4; ++m) { const int r = rl0 + ai * 128 + m * 16; const int k32 = r & 31; const int rp = (r & ~31) + 8 * ((k32 >> 2) & 3) + 4 * (k32 >> 4) + (k32 & 3);
#pragma unroll
                    for (int bj = 0; bj < 2; ++bj)
#pragma unroll
                        for (int n = 0; n < 2; ++n)
#pragma unroll
                            for (int j = 0; j < 4; ++j) VT[(size_t)(colb + bj * 128 + n * 16 + j) * TA + rp] = (bf16_t)f2bf(acc[ai][bj][m][n][j]); }
        }
    }
};


#define XB_TMO      128
#define XB_XCNT(j)  (256  + 64 * (j))
#define XB_XSUB(j)  (1280 + 64 * (j))
#define XB_XGEN(j)  (2304 + 64 * (j))
#define XB_TOP      3328
#define XB_TOPGEN   3392
#define XCD_BAR_WORDS 3456
#define XB_SPIN_CAP (1u << 22)
__device__ __forceinline__ unsigned xb_ld(unsigned* p)              { return __hip_atomic_load(p, __ATOMIC_RELAXED, __HIP_MEMORY_SCOPE_AGENT); }
__device__ __forceinline__ unsigned xb_add(unsigned* p, unsigned v) { return __hip_atomic_fetch_add(p, v, __ATOMIC_RELAXED, __HIP_MEMORY_SCOPE_AGENT); }
__device__ __forceinline__ unsigned xb_xcc_id() { return (unsigned)__builtin_amdgcn_s_getreg((3 << 11) | 20) & 0xFu; }
#define XB_SPIN(cond, bar) do { unsigned _sp = 0; while (cond) { __builtin_amdgcn_s_sleep(1); \
    if ((++_sp & 255u) == 0u) { if (xb_ld(&(bar)[XB_TMO])) break; if (_sp > XB_SPIN_CAP) { atomicAdd(&(bar)[XB_TMO], 1u); break; } } } } while (0)
struct XcdBarrier { unsigned* bar; unsigned x; volatile LAS unsigned* st; };
__device__ __forceinline__ XcdBarrier xcd_barrier_post(unsigned* bar, volatile LAS unsigned* st) {
    XcdBarrier b; b.bar = bar; b.x = xb_xcc_id(); b.st = st;
    if (threadIdx.x == 0) (void)xb_add(&bar[XB_XCNT(b.x)], 1u);
    return b;
}
__device__ __forceinline__ void xcd_barrier_complete(unsigned* bar, unsigned x, unsigned& nloc, unsigned& nx) {
    const unsigned G = gridDim.x * gridDim.y * gridDim.z;
    unsigned sum, cnt, mine, sp = 0u;
    for (;;) {
        sum = 0u; cnt = 0u; mine = 0u;
#pragma unroll
        for (unsigned j = 0; j < 16; ++j) { const unsigned c = xb_ld(&bar[XB_XCNT(j)]); sum += c; cnt += (c > 0u) ? 1u : 0u; mine = (j == x) ? c : mine; }
        if (sum == G) break;
        __builtin_amdgcn_s_sleep(1);
        if ((++sp & 255u) == 0u) { if (xb_ld(&bar[XB_TMO])) break; if (sp > XB_SPIN_CAP) { atomicAdd(&bar[XB_TMO], 1u); break; } }
    }
    nloc = mine > 0u ? mine : 1u; nx = cnt > 0u ? cnt : 1u;
}
__device__ __forceinline__ void xcd_barrier(const XcdBarrier& b) {
    asm volatile("s_waitcnt vmcnt(0)" ::: "memory");
    __syncthreads();
    if (threadIdx.x == 0) {
        unsigned* bar = b.bar;
        __builtin_amdgcn_s_waitcnt(0);
        unsigned nloc = b.st[0], nx = b.st[1];
        if (nloc == 0u) { xcd_barrier_complete(bar, b.x, nloc, nx); b.st[0] = nloc; b.st[1] = nx; }
        const unsigned old = xb_add(&bar[XB_XSUB(b.x)], 1u);
        const unsigned gen = old / nloc;
        if (old + 1u == (gen + 1u) * nloc) {
            __builtin_amdgcn_fence(__ATOMIC_RELEASE, "agent");
            asm volatile("s_waitcnt vmcnt(0)" ::: "memory");
            const unsigned og = xb_add(&bar[XB_TOP], 1u);
            const unsigned tg = og / nx;
            if (og + 1u == (tg + 1u) * nx) xb_add(&bar[XB_TOPGEN], 1u);
            else XB_SPIN(xb_ld(&bar[XB_TOPGEN]) == tg, bar);
            __builtin_amdgcn_fence(__ATOMIC_ACQUIRE, "agent");
            xb_add(&bar[XB_XGEN(b.x)], 1u);
            asm volatile("s_waitcnt vmcnt(0)" ::: "memory");
        } else {
            XB_SPIN(xb_ld(&bar[XB_XGEN(b.x)]) == gen, bar);
            __builtin_amdgcn_fence(__ATOMIC_ACQUIRE, "agent");
            asm volatile("s_waitcnt vmcnt(0)" ::: "memory");
        }
    }
    __syncthreads();
}

struct Args { const float* in[37]; float* out; unsigned char* ws; };
enum { I_X = 0, I_C, I_CTX, I_CCTX, I_ADAW, I_ADAB, I_LN1G, I_LN1B, I_LN2G, I_LN2B, I_WUP, I_CONVW, I_CONVB, I_WDN, I_POOLW, I_POOLB, I_POOLS,
       I_WQKV, I_WOUT, I_SINK, I_LRE, I_LIM, I_LDT, I_BRE, I_BIM, I_CRE, I_CIM, I_SSMD, I_GLUA, I_GLUB, I_GWIN, I_GBIN, I_GLNG, I_GLNB, I_GWS, I_GBS, I_GWOUT };

struct Ctx { int tid, lane, wid, bid, nb, gw, ngw; LAS unsigned char* lds; };
typedef const __attribute__((address_space(4))) Args* KArgsPtr;
__device__ __forceinline__ KArgsPtr kargs() { KArgsPtr p = (KArgsPtr)__builtin_amdgcn_kernarg_segment_ptr(); asm volatile("" : "+s"(p)); return p; }
#define AIN(i) ((const float*)(kargs()->in[i]))

__device__ __forceinline__ void conv_weight(const Ctx& c, const float* W, int K, int N, bf16_t* WT, int mode) {
    LAS float* scr = (LAS float*)(c.lds + c.wid * 16384);
    const int nblk = N / 32, nitems = (K / 64) * nblk, lane = c.lane;
    for (int it = c.gw; it < nitems; it += c.ngw) {
        const int kb = it / nblk, nbk = it % nblk, k0 = 64 * kb, n0 = 32 * nbk;
        const int d0 = mode == 0 ? n0 : ((n0 >> 7) * 256 + (n0 & 127) + (mode == 2 ? 128 : 0));
#pragma unroll 8
        for (int i = 0; i < 32; ++i) { const int kk = 2 * i + (lane >> 5); scr[kk * 33 + (lane & 31)] = __builtin_nontemporal_load(W + (size_t)(k0 + kk) * N + n0 + (lane & 31)); }
        LDS_WAIT();
        const int cc = lane & 7;
#pragma unroll
        for (int j = 0; j < 4; ++j) { const int n = (lane >> 3) + 8 * j; const LAS float* s = scr + (8 * cc) * 33 + n;
            u32x4 o; o.x = pk2(s[0 * 33], s[1 * 33]); o.y = pk2(s[2 * 33], s[3 * 33]); o.z = pk2(s[4 * 33], s[5 * 33]); o.w = pk2(s[6 * 33], s[7 * 33]);
            *(u32x4*)(WT + (size_t)(d0 + n) * K + k0 + 8 * cc) = o; }
        LDS_WAIT();
    }
}
__device__ __forceinline__ void conv_plain(const Ctx& c, const float* W, bf16_t* O, int n) {
    for (int i = (c.bid * 512 + c.tid) * 4; i < n; i += c.nb * 512 * 4) { const f32x4 v = *(const f32x4*)(W + i); u32x2 w; w.x = pk2(v[0], v[1]); w.y = pk2(v[2], v[3]); *(u32x2*)(O + i) = w; }
}

__device__ __forceinline__ void cpow(float lre, float lim, float dt, int n, float& re, float& im) {
    const float mag = __expf(lre * dt * (float)n);
    double rev = (double)lim * (double)dt * (double)n * 0.15915494309189535;
    rev -= __builtin_rint(rev);
    const float r = (float)rev;
    re = mag * __builtin_amdgcn_cosf(r); im = mag * __builtin_amdgcn_sinf(r);
}
__device__ __forceinline__ void ssm_load_params(const Args& a, int d, int g, int tid, LAS float* lam, LAS float* dtp, LAS f32x2* bb, LAS f32x2* cc) {
    const int dg = d * 64 + g;
    const float dt = __expf(AIN(I_LDT)[dg]);
    if (tid < 64) { lam[2 * tid] = AIN(I_LRE)[dg * 64 + tid]; lam[2 * tid + 1] = AIN(I_LIM)[dg * 64 + tid]; }
    if (tid == 0) dtp[0] = dt;
    for (int i = tid; i < 1024; i += 512) {
        const int p = i >> 4;
        const float lre = AIN(I_LRE)[dg * 64 + p], lim = AIN(I_LIM)[dg * 64 + p];
        const float x = lre * dt, y = lim * dt;
        float cr, ci; { double rev = (double)lim * (double)dt * 0.15915494309189535; rev -= __builtin_rint(rev); const float r = (float)rev; cr = __builtin_amdgcn_cosf(r); ci = __builtin_amdgcn_sinf(r); }
        const float em1 = expm1f(x), ex = em1 + 1.0f;
        const float cm1 = (fabsf(y) < 0.25f) ? (-0.5f * y * y + (1.0f / 24.0f) * y * y * y * y - (1.0f / 720.0f) * y * y * y * y * y * y) : (cr - 1.0f);
        const float nr = em1 * cr + cm1, ni = ex * ci;
        const float den = 1.0f / (lre * lre + lim * lim);
        const float qr = (nr * lre + ni * lim) * den, qi = (ni * lre - nr * lim) * den;
        const float br = AIN(I_BRE)[(size_t)dg * 1024 + i], bi = AIN(I_BIM)[(size_t)dg * 1024 + i];
        bb[i] = (f32x2){qr * br - qi * bi, qr * bi + qi * br};
        cc[i] = (f32x2){AIN(I_CRE)[(size_t)dg * 1024 + i], AIN(I_CIM)[(size_t)dg * 1024 + i]};
    }
}

__device__ __forceinline__ void phase0(const Args& a, const Ctx& c) {
    unsigned char* ws = a.ws;
    {
        LAS float* sc = (LAS float*)c.lds;
        LAS float* red = (LAS float*)(c.lds + 20480);
        for (int i = c.tid; i < 5 * 1024; i += 512) { const int cnd = i >> 10, k = i & 1023; const float v = cnd < 4 ? AIN(I_C)[cnd * 1024 + k] : AIN(I_CCTX)[k]; sc[i] = siluf_(v); }
        __syncthreads();
        const int cl = c.tid & 15, kg = c.tid >> 4;
        for (int it = c.bid; it < 4 * 96; it += c.nb) {
            const int layer = it / 96, col0 = (it % 96) * 64;
            const float* W = AIN(I_ADAW) + (size_t)layer * 1024 * 6144 + col0 + 4 * cl;
            f32x4 acc[5];
#pragma unroll
            for (int q = 0; q < 5; ++q) acc[q] = (f32x4){0.f, 0.f, 0.f, 0.f};
#pragma unroll 8
            for (int kk = 0; kk < 32; ++kk) { const int k = kg * 32 + kk; const f32x4 w = __builtin_nontemporal_load((const f32x4*)(W + (size_t)k * 6144));
#pragma unroll
                for (int q = 0; q < 5; ++q) { const float s = sc[q * 1024 + k]; acc[q] += w * s; } }
#pragma unroll
            for (int q = 0; q < 5; ++q) *(LAS f32x4*)(red + (kg * 5 + q) * 64 + 4 * cl) = acc[q];
            __syncthreads();
            if (c.tid < 320) { const int q = c.tid >> 6, col = c.tid & 63; float s = AIN(I_ADAB)[layer * 6144 + col0 + col];
                for (int k2 = 0; k2 < 32; ++k2) s += red[(k2 * 5 + q) * 64 + col];
                ((float*)(ws + WS_MODS))[(layer * 5 + q) * 6144 + col0 + col] = s; }
            __syncthreads();
        }
    }
    for (int i = c.bid * 512 + c.tid; i < 2 * TL; i += c.nb * 512) ((float*)(ws + WS_VSTAT))[i] = 0.f;
    for (int i = c.bid * 512 + c.tid; i < 8 * TL * 2 + 8 * 64 * 64; i += c.nb * 512) ((unsigned*)(ws + WS_LNSTAT))[i] = 0u;
    for (int i = c.bid * 512 + c.tid; i < 64 * 16; i += c.nb * 512) { const int pos = i >> 4, k = i & 15; const float f = exp2f(-(float)k * (13.287712379549449f / 16.0f)); float s, co; __sincosf((float)pos * f, &s, &co);
        ((float*)(ws + WS_ROPE))[2 * i] = co; ((float*)(ws + WS_ROPE))[2 * i + 1] = s; }
    {
        LAS float* lam = (LAS float*)c.lds;
        LAS float* dtp = lam + 256;
        LAS f32x2* bb = (LAS f32x2*)(c.lds + 2048);
        LAS f32x2* cc = bb + 2048;
        LAS f32x2* Q = cc + 2048;
        for (int it = c.bid; it < 64 * 8; it += c.nb) {
            const int g = it >> 3, sl = it & 7;
            __syncthreads();
            ssm_load_params(a, 0, g, c.tid, lam, dtp, bb, cc);
            ssm_load_params(a, 1, g, c.tid, lam + 128, dtp + 1, bb + 1024, cc + 1024);
            __syncthreads();
            for (int li = sl * 16; li < sl * 16 + 16 && li < 127; ++li) {
                float out = 0.f;
                for (int d = 0; d < 2; ++d) {
                    int tau; if (d == 0) { if (li < 63) continue; tau = li - 63; } else { if (li > 63) continue; tau = 63 - li; }
                    __syncthreads();
                    for (int i = c.tid; i < 1024; i += 512) { const int p = i & 63; float pr, pi; cpow(lam[d * 128 + 2 * p], lam[d * 128 + 2 * p + 1], dtp[d], tau, pr, pi);
                        const f32x2 cv = cc[d * 1024 + i]; Q[i] = (f32x2){cv.x * pr - cv.y * pi, cv.x * pi + cv.y * pr}; }
                    __syncthreads();
                    if (c.tid < 256) { const int cq = c.tid >> 4, cp = c.tid & 15;
                        for (int p = 0; p < 64; ++p) { const f32x2 q = Q[cq * 64 + p], b = bb[d * 1024 + p * 16 + cp]; out += q.x * b.x - q.y * b.y; } }
                }
                if (c.tid < 256) ((bf16_t*)(ws + WS_KK))[((size_t)(g * 127 + li)) * 256 + c.tid] = (bf16_t)f2bf(out);
            }
        }
        __syncthreads();
    }
    conv_weight(c, AIN(I_WUP), 1024, F2, (bf16_t*)(ws + WS_WUP), 0);
    conv_weight(c, AIN(I_WDN), FH, 1024, (bf16_t*)(ws + WS_WDN), 0);
    for (int g = 0; g < 4; ++g) conv_weight(c, AIN(I_POOLW) + g * 65536, 256, 256, (bf16_t*)(ws + WS_WPOOL) + g * 65536, 0);
    conv_weight(c, AIN(I_WQKV), 1024, 1536, (bf16_t*)(ws + WS_WQKV), 0);
    conv_weight(c, AIN(I_WOUT), 1024, 1024, (bf16_t*)(ws + WS_WO), 0);
    conv_weight(c, AIN(I_GLUA), 1024, 1024, (bf16_t*)(ws + WS_WGLU), 1);
    conv_weight(c, AIN(I_GLUB), 1024, 1024, (bf16_t*)(ws + WS_WGLU), 2);
    conv_weight(c, AIN(I_GWIN), 1024, 4096, (bf16_t*)(ws + WS_WGIN), 0);
    conv_weight(c, AIN(I_GWOUT), 2048, 1024, (bf16_t*)(ws + WS_WGOUT), 0);
    conv_plain(c, AIN(I_GWS), (bf16_t*)(ws + WS_WS16), 8 * 128 * 128);
}

__device__ __forceinline__ void ssm_tables(const Args& a, const Ctx& c) {
    unsigned char* ws = a.ws;
    LAS float* lam = (LAS float*)c.lds; LAS float* dtp = lam + 128;
    LAS f32x2* bb = (LAS f32x2*)(c.lds + 2048); LAS f32x2* cc = bb + 1024; LAS f32x2* P = cc + 1024;
    for (int it = c.bid; it < 128; it += c.nb) {
        const int d = it >> 6, g = it & 63;
        __syncthreads();
        ssm_load_params(a, d, g, c.tid, lam, dtp, bb, cc);
        __syncthreads();
        for (int i = c.tid; i < 65 * 64; i += 512) { const int n = i >> 6, p = i & 63; float pr, pi; cpow(lam[2 * p], lam[2 * p + 1], dtp[0], n, pr, pi); P[i] = (f32x2){pr, pi}; }
        __syncthreads();
        if (c.tid < 64) ((f32x2*)(ws + WS_LAML))[(d * 64 + g) * 64 + c.tid] = P[64 * 64 + c.tid];
        bf16_t* ET = (bf16_t*)(ws + WS_ET) + (size_t)(d * 64 + g) * 128 * 1024;
        for (int i = c.tid; i < 64 * 128; i += 512) {
            const int p = i >> 7, kg8 = i & 127, tp = kg8 >> 1, c0 = (kg8 & 1) * 8;
            const f32x2 pw = P[(d ? tp : 63 - tp) * 64 + p];
            float re[8], im[8];
#pragma unroll
            for (int j = 0; j < 8; ++j) { const f32x2 b = bb[p * 16 + c0 + j]; re[j] = pw.x * b.x - pw.y * b.y; im[j] = pw.x * b.y + pw.y * b.x; }
            u32x4 wr_, wi_; wr_.x = pk2(re[0], re[1]); wr_.y = pk2(re[2], re[3]); wr_.z = pk2(re[4], re[5]); wr_.w = pk2(re[6], re[7]);
            wi_.x = pk2(im[0], im[1]); wi_.y = pk2(im[2], im[3]); wi_.z = pk2(im[4], im[5]); wi_.w = pk2(im[6], im[7]);
            *(u32x4*)(ET + (size_t)(2 * p) * 1024 + kg8 * 8) = wr_; *(u32x4*)(ET + (size_t)(2 * p + 1) * 1024 + kg8 * 8) = wi_;
        }
        bf16_t* GT = (bf16_t*)(ws + WS_GT) + (size_t)(d * 64 + g) * 1024 * 128;
        for (int i = c.tid; i < 1024 * 16; i += 512) {
            const int n = i >> 4, p0 = (i & 15) * 4, t = n >> 4, cq = n & 15;
            float v[8];
#pragma unroll
            for (int j = 0; j < 4; ++j) { const f32x2 pw = P[(d ? 64 - t : t + 1) * 64 + p0 + j], cv = cc[cq * 64 + p0 + j]; v[2 * j] = cv.x * pw.x - cv.y * pw.y; v[2 * j + 1] = -(cv.x * pw.y + cv.y * pw.x); }
            u32x4 w; w.x = pk2(v[0], v[1]); w.y = pk2(v[2], v[3]); w.z = pk2(v[4], v[5]); w.w = pk2(v[6], v[7]);
            *(u32x4*)(GT + (size_t)n * 128 + 2 * p0) = w;
        }
    }
    __syncthreads();
}

__device__ __forceinline__ void ln_pass(const Ctx& c, int row_begin, int M, float* res_lat, float* res_ctx, const float* g, const float* b, bf16_t* H, const float* mods, int sh_off, int sc_off, const float* parts, int nks, const float* mods_gate, int gate_off, int hgm = 0) {
    float* const dry = nullptr;
    for (int row0 = row_begin + 2 * c.gw; row0 < M; row0 += 2 * c.ngw) {
        f32x4* xr[2]; f32x4 v[2][4]; float s[2];
#pragma unroll
        for (int r = 0; r < 2; ++r) { const int row = row0 + r; float* p = row < TL ? res_lat + (size_t)row * D : res_ctx + (size_t)(row - TL) * D; xr[r] = (f32x4*)p + c.lane;
#pragma unroll
            for (int j = 0; j < 4; ++j) v[r][j] = xr[r][64 * j];
        }
        if (parts != nullptr && row0 >= TL) {
            f32x4 ps[2][4];
#pragma unroll
            for (int r = 0; r < 2; ++r)
#pragma unroll
                for (int j = 0; j < 4; ++j) ps[r][j] = (f32x4){0.f, 0.f, 0.f, 0.f};
#pragma unroll 1
            for (int ks = 0; ks < nks; ++ks) {
                const f32x4* pr = (const f32x4*)(parts + (size_t)ks * 1024 * 1024 + (size_t)(row0 - TL) * D) + c.lane;
#pragma unroll
                for (int r = 0; r < 2; ++r)
#pragma unroll
                    for (int j = 0; j < 4; ++j) ps[r][j] += pr[r * 256 + 64 * j];
            }
#pragma unroll
            for (int j = 0; j < 4; ++j) { const f32x4 g4 = *(const f32x4*)(mods_gate + 4 * 6144 + gate_off + 4 * c.lane + 256 * j);
#pragma unroll
                for (int r = 0; r < 2; ++r) v[r][j] = ALPHA * v[r][j] + g4 * ps[r][j]; }
        }
#pragma unroll
        for (int r = 0; r < 2; ++r) { s[r] = 0.f;
#pragma unroll
            for (int j = 0; j < 4; ++j) s[r] += (v[r][j][0] + v[r][j][1]) + (v[r][j][2] + v[r][j][3]); }
        float mean[2], rstd[2];
#pragma unroll
        for (int r = 0; r < 2; ++r) mean[r] = wave_sum(s[r]) * (1.f / D);
#pragma unroll
        for (int r = 0; r < 2; ++r) { float s2 = 0.f;
#pragma unroll
            for (int j = 0; j < 4; ++j) { v[r][j] = v[r][j] - mean[r]; s2 += (v[r][j][0] * v[r][j][0] + v[r][j][1] * v[r][j][1]) + (v[r][j][2] * v[r][j][2] + v[r][j][3] * v[r][j][3]); }
            s[r] = s2; }
#pragma unroll
        for (int r = 0; r < 2; ++r) rstd[r] = __builtin_amdgcn_rsqf(wave_sum(s[r]) * (1.f / D) + LN_EPS);
        const int cond = row0 < TL ? (row0 >> 12) : 4;
#pragma unroll
        for (int j = 0; j < 4; ++j) { const int col = 4 * c.lane + 256 * j; const f32x4 g4 = *(const f32x4*)(g + col), b4 = *(const f32x4*)(b + col);
            f32x4 sh = (f32x4){0.f, 0.f, 0.f, 0.f}, sc = sh;
            if (H) { sh = *(const f32x4*)(mods + cond * 6144 + sh_off + col); sc = 1.0f + *(const f32x4*)(mods + cond * 6144 + sc_off + col); }
#pragma unroll
            for (int r = 0; r < 2; ++r) { const int row = row0 + r;
                const f32x4 x = v[r][j] * rstd[r] * g4 + b4;
                if (dry) ((f32x4*)(dry + (size_t)row * D))[c.lane + 64 * j] = x; else xr[r][64 * j] = x;
                if (H) { const f32x4 h = x * sc + sh; u32x2 w; w.x = pk2(h[0], h[1]); w.y = pk2(h[2], h[3]);
                    if (hgm) *(u32x2*)(H + ((size_t)(col >> 4) * TA + row) * 16 + (col & 15)) = w; else *(u32x2*)(H + (size_t)row * D + col) = w; } } }
    }
}

template <int W> __device__ __forceinline__ void pool_rows(const float* __restrict__ src, int t0, int n, f32x4 sc1, bf16_t* __restrict__ dst) {
    f32x4 R[8 + W - 1];
#pragma unroll
    for (int q = 0; q < 8 + W - 1; ++q) { const int t = t0 - W / 2 + q; R[q] = (t >= 0 && t < n) ? *(const f32x4*)(src + (size_t)t * D) : (f32x4){0.f, 0.f, 0.f, 0.f}; }
#pragma unroll
    for (int i = 0; i < 8; ++i) {
        f32x4 s = R[i];
#pragma unroll
        for (int k = 1; k < W; ++k) s += R[i + k];
        const int t = t0 + i, lo = max(t - W / 2, 0), hi = min(t - W / 2 + W, n);
        const f32x4 mx = (s * __builtin_amdgcn_rcpf((float)(hi - lo)) - R[i + W / 2]) * sc1;
        u32x2 o; o.x = pk2(mx[0], mx[1]); o.y = pk2(mx[2], mx[3]);
        *(u32x2*)(dst + (size_t)i * D) = o;
    }
}
__device__ __forceinline__ void pool_mix(const Args& a, const Ctx& c, const float* mods0, bf16_t* MIX) {
    for (int item = c.bid * 512 + c.tid; item < (TA / 8) * 256; item += c.nb * 512) {
        const int row0 = (item >> 8) * 8, col = (item & 255) * 4, grp = col >> 8;
        const float* src; int t0, n, cond;
        if (row0 < TL) { t0 = row0 & 4095; n = SEQ; src = AIN(I_X) + (size_t)(row0 - t0) * D + col; cond = row0 >> 12; }
        else { const int rr = row0 - TL; t0 = rr & 255; n = CTXL; src = AIN(I_CTX) + (size_t)(rr - t0) * D + col; cond = 4; }
        const f32x4 sc1 = 1.0f + *(const f32x4*)(mods0 + cond * 6144 + MOD_SC1 + col);
        bf16_t* dst = MIX + (size_t)row0 * D + col;
        if (grp == 0) pool_rows<2>(src, t0, n, sc1, dst);
        else if (grp == 1) pool_rows<4>(src, t0, n, sc1, dst);
        else if (grp == 2) pool_rows<8>(src, t0, n, sc1, dst);
        else pool_rows<16>(src, t0, n, sc1, dst);
    }
}

struct CgRow { u32x4 v, g; };
__device__ __forceinline__ CgRow cg_load(const bf16_t* p, bool ok) { CgRow r; const u32x4 z = (u32x4){0u, 0u, 0u, 0u}; r.v = ok ? __builtin_nontemporal_load((const u32x4*)p) : z; r.g = ok ? __builtin_nontemporal_load((const u32x4*)(p + FH)) : z; return r; }
__device__ __forceinline__ void conv_gate(const Ctx& c, int M, const bf16_t* __restrict__ A, bf16_t* __restrict__ HID, const float* __restrict__ cw, const float* __restrict__ cb) {
    const int nitems = (M >> 4) * 352;
    for (int item = c.bid * 512 + c.tid; item < nitems; item += c.nb * 512) {
        const int chunk = item / 352, j = (item - chunk * 352) * 8, row0 = chunk * 16;
        int t0, n; if (row0 < TL) { t0 = row0 & 4095; n = SEQ; } else { t0 = (row0 - TL) & 255; n = CTXL; }
        f32x4 wv[3][2], wg[3][2], bv[2], bg[2];
#pragma unroll
        for (int tap = 0; tap < 3; ++tap)
#pragma unroll
            for (int h = 0; h < 2; ++h) { wv[tap][h] = *(const f32x4*)(cw + tap * F2 + j + 4 * h); wg[tap][h] = *(const f32x4*)(cw + tap * F2 + FH + j + 4 * h); }
#pragma unroll
        for (int h = 0; h < 2; ++h) { bv[h] = *(const f32x4*)(cb + j + 4 * h); bg[h] = *(const f32x4*)(cb + FH + j + 4 * h); }
        const bf16_t* ap = A + (size_t)row0 * F2 + j;
        CgRow R[5];
        R[0] = cg_load(ap - F2, t0 > 0);
#pragma unroll
        for (int q = 1; q < 5; ++q) R[q] = cg_load(ap + (size_t)(q - 1) * F2, true);
#pragma unroll
        for (int i = 0; i < 16; ++i) {
            const CgRow& P = R[i % 5]; const CgRow& C = R[(i + 1) % 5]; const CgRow& Nx = R[(i + 2) % 5];
            unsigned o[4];
#pragma unroll
            for (int q = 0; q < 4; ++q) {
                const int h = q >> 1, e = (q & 1) * 2;
                const float v0 = bv[h][e] + bflo(P.v[q]) * wv[0][h][e] + bflo(C.v[q]) * wv[1][h][e] + bflo(Nx.v[q]) * wv[2][h][e];
                const float v1 = bv[h][e + 1] + bfhi(P.v[q]) * wv[0][h][e + 1] + bfhi(C.v[q]) * wv[1][h][e + 1] + bfhi(Nx.v[q]) * wv[2][h][e + 1];
                const float g0 = bg[h][e] + bflo(P.g[q]) * wg[0][h][e] + bflo(C.g[q]) * wg[1][h][e] + bflo(Nx.g[q]) * wg[2][h][e];
                const float g1 = bg[h][e + 1] + bfhi(P.g[q]) * wg[0][h][e + 1] + bfhi(C.g[q]) * wg[1][h][e + 1] + bfhi(Nx.g[q]) * wg[2][h][e + 1];
                o[q] = pk2(v0 * siluf_(g0), v1 * siluf_(g1));
            }
            *(u32x4*)(HID + (size_t)(row0 + i) * FH + j) = (u32x4){o[0], o[1], o[2], o[3]};
            if (i + 4 <= 16) { const bool ok = (i + 4 < 16) || (t0 + 16 < n); R[i % 5] = cg_load(ap + (size_t)(i + 4) * F2, ok); }
        }
    }
}

constexpr int ANQ = 4;
__device__ __forceinline__ void att_load(bf16x8 (&KF)[2][2], bf16x8 (&VF)[4], const bf16_t* __restrict__ QK, const bf16_t* __restrict__ VT, int kr, int hk, int l15, int q4) {
#pragma unroll
    for (int kb = 0; kb < 2; ++kb)
#pragma unroll
        for (int ks = 0; ks < 2; ++ks) KF[kb][ks] = *(const bf16x8*)(QK + (size_t)(kr + 16 * kb + l15) * 1280 + 1024 + 64 * hk + 32 * ks + 8 * q4);
#pragma unroll
    for (int db = 0; db < 4; ++db) VF[db] = *(const bf16x8*)(VT + (size_t)(64 * hk + 16 * db + l15) * TA + kr + 8 * q4);
}
__device__ __forceinline__ void att_tile(const bf16x8 (&KF)[2][2], const bf16x8 (&VF)[4], const bf16x8 (&QF)[ANQ][2], f32x4 (&Oa)[ANQ][4], float (&mrun)[ANQ], float (&lrun)[ANQ],
                                         bool need_mask, int kpos0, int qoff, int l15, int q4) {
    const float C2 = 0.18033688011112042f;
#pragma unroll
    for (int qb = 0; qb < ANQ; ++qb) {
        f32x4 s[2];
#pragma unroll
        for (int kb = 0; kb < 2; ++kb) { s[kb] = mfma16(KF[kb][0], QF[qb][0], (f32x4){0.f, 0.f, 0.f, 0.f}); s[kb] = mfma16(KF[kb][1], QF[qb][1], s[kb]); }
        if (need_mask) { const int qpos = qoff + 16 * qb + l15;
#pragma unroll
            for (int kb = 0; kb < 2; ++kb)
#pragma unroll
                for (int j = 0; j < 4; ++j) { const int dlt = kpos0 + 16 * kb + 4 * q4 + j - qpos; if (dlt > 128 || dlt < -128) s[kb][j] = -1e30f; } }
        float mx = fmaxf(fmaxf(fmaxf(s[0][0], s[0][1]), fmaxf(s[0][2], s[0][3])), fmaxf(fmaxf(s[1][0], s[1][1]), fmaxf(s[1][2], s[1][3])));
        mx = fmaxf(mx, __shfl_xor(mx, 16)); mx = fmaxf(mx, __shfl_xor(mx, 32));
        if (__builtin_amdgcn_ballot_w64(mx > mrun[qb]) != 0ull) {
            const float mnew = fmaxf(mrun[qb], mx), corr = __builtin_amdgcn_exp2f((mrun[qb] - mnew) * C2);
            mrun[qb] = mnew; lrun[qb] *= corr;
#pragma unroll
            for (int db = 0; db < 4; ++db) Oa[qb][db] = Oa[qb][db] * corr;
        }
        const float nm = -mrun[qb] * C2;
        float p[8];
#pragma unroll
        for (int kb = 0; kb < 2; ++kb)
#pragma unroll
            for (int j = 0; j < 4; ++j) p[kb * 4 + j] = __builtin_amdgcn_exp2f(fmaf(s[kb][j], C2, nm));
        lrun[qb] += ((p[0] + p[1]) + (p[2] + p[3])) + ((p[4] + p[5]) + (p[6] + p[7]));
        u32x4 pw; pw.x = pk2(p[0], p[1]); pw.y = pk2(p[2], p[3]); pw.z = pk2(p[4], p[5]); pw.w = pk2(p[6], p[7]);
        const bf16x8 PF = __builtin_bit_cast(bf16x8, pw);
#pragma unroll
        for (int db = 0; db < 4; ++db) Oa[qb][db] = mfma16(VF[db], PF, Oa[qb][db]);
    }
}
__device__ __forceinline__ void attn_phase(const Args& a, const Ctx& c, const bf16_t* QK, const bf16_t* VT, bf16_t* O) {
    const int lane = c.lane, w = c.wid, l15 = lane & 15, q4 = lane >> 4;
    const float* sink = AIN(I_SINK);
    for (int it = c.bid; it < 512 + 32; it += c.nb) {
        int b, nbq, hk; const bool isctx = it >= 512;
        if (!isctx) { hk = it & 3; nbq = (it >> 2) & 31; b = it >> 7; }
        else { const int i2 = it - 512; hk = i2 & 3; nbq = (i2 >> 2) & 1; b = i2 >> 3; }
        const int hq = hk * 4 + (w >> 1);
        const int qoff = nbq * 128 + 64 * (w & 1);
        const int r0 = (isctx ? TL + b * CTXL : b * SEQ) + qoff;
        bf16x8 QF[ANQ][2];
#pragma unroll
        for (int qb = 0; qb < ANQ; ++qb)
#pragma unroll
            for (int ks = 0; ks < 2; ++ks) QF[qb][ks] = *(const bf16x8*)(QK + (size_t)(r0 + 16 * qb + l15) * 1280 + 64 * hq + 32 * ks + 8 * q4);
        f32x4 Oa[ANQ][4]; float mrun[ANQ], lrun[ANQ];
        const float sk = sink[hq] * 8.0f;
#pragma unroll
        for (int qb = 0; qb < ANQ; ++qb) { mrun[qb] = sk; lrun[qb] = (q4 == 0) ? 1.0f : 0.0f;
#pragma unroll
            for (int db = 0; db < 4; ++db) Oa[qb][db] = (f32x4){0.f, 0.f, 0.f, 0.f}; }
        int kp0 = 0, kp1 = 0;
        if (!isctx) { kp0 = max(0, 128 * (nbq - 1)); kp1 = min(SEQ, 128 * (nbq + 2)); kp0 = max(kp0, (qoff - 128) & ~31); kp1 = min(kp1, ((qoff + 63 + 128) & ~31) + 32); }
        const int nband = (kp1 - kp0) >> 5, nt = nband + 8;
        const int krb = b * SEQ + kp0, krc = TL + b * CTXL;
#define ATT_KR(TT) ((TT) < nband ? krb + 32 * (TT) : krc + 32 * ((TT) - nband))
#define ATT_MASK(TT) ((TT) < nband && ((kp0 + 32 * (TT) + 31 - qoff > 128) || (kp0 + 32 * (TT) - (qoff + 63) < -128)))
        bf16x8 KA[2][2], VA[4], KB[2][2], VB[4];
        att_load(KA, VA, QK, VT, ATT_KR(0), hk, l15, q4);
        for (int tt = 0; tt < nt; tt += 2) {
            if (tt + 1 < nt) att_load(KB, VB, QK, VT, ATT_KR(tt + 1), hk, l15, q4);
            att_tile(KA, VA, QF, Oa, mrun, lrun, ATT_MASK(tt), kp0 + 32 * tt, qoff, l15, q4);
            if (tt + 1 < nt) {
                if (tt + 2 < nt) att_load(KA, VA, QK, VT, ATT_KR(tt + 2), hk, l15, q4);
                att_tile(KB, VB, QF, Oa, mrun, lrun, ATT_MASK(tt + 1), kp0 + 32 * (tt + 1), qoff, l15, q4);
            }
        }
#undef ATT_KR
#undef ATT_MASK
#pragma unroll
        for (int qb = 0; qb < ANQ; ++qb) {
            float l = lrun[qb]; l += __shfl_xor(l, 16); l += __shfl_xor(l, 32);
            const float inv = __builtin_amdgcn_rcpf(l);
            bf16_t* op = O + (size_t)(r0 + 16 * qb + l15) * D + 64 * hq + 4 * q4;
#pragma unroll
            for (int db = 0; db < 4; ++db) { const f32x4 o = Oa[qb][db] * inv; u32x2 wv; wv.x = pk2(o[0], o[1]); wv.y = pk2(o[2], o[3]); *(u32x2*)(op + 16 * db) = wv; }
        }
    }
}

__device__ __forceinline__ int ssm_chunk_row(int d, int b, int k) {
    if (d == 0) return k < 4 ? TL + b * CTXL + 64 * k : b * SEQ + 64 * (k - 4);
    return k < 4 ? TL + b * CTXL + 64 * (3 - k) : b * SEQ + 64 * (67 - k);
}
__device__ __forceinline__ void ssm_s1(const Ctx& c, const bf16_t* __restrict__ H, const bf16_t* __restrict__ ET, float* __restrict__ SLOC) {
    const int l15 = c.lane & 15, q4 = c.lane >> 4, w = c.wid;
    LAS unsigned char* ETs = c.lds;
    LAS unsigned char* Us = c.lds + 17408;
    for (int it = c.bid; it < 256; it += c.nb) {
        const int dg = it >> 1, nh = it & 1, d = dg >> 6, g = dg & 63;
        const int nbk = w >> 1, mp = w & 1;
        f32x4 acc[9];
#pragma unroll
        for (int i = 0; i < 9; ++i) acc[i] = (f32x4){0.f, 0.f, 0.f, 0.f};
        u32x4 pe[2], pu[9];
#define S1_FETCH(KC) do { _Pragma("unroll") for (int q = 0; q < 2; ++q) { const int i = c.tid + 512 * q; const int n = i >> 4, pc = i & 15; \
                pe[q] = *(const u32x4*)(ET + ((size_t)dg * 128 + 64 * nh + n) * 1024 + 128 * (KC) + 8 * pc); } \
            _Pragma("unroll") for (int q = 0; q < 9; ++q) { const int i = c.tid + 512 * q; if (i < 272 * 16) { const int m = i >> 4, pc = i & 15, b = m / 68, k = m - b * 68; \
                pu[q] = *(const u32x4*)(H + ((size_t)g * TA + ssm_chunk_row(d, b, k) + 8 * (KC) + (pc >> 1)) * 16 + 8 * (pc & 1)); } } } while (0)
        S1_FETCH(0);
        for (int kc = 0; kc < 8; ++kc) {
            __syncthreads();
#pragma unroll
            for (int q = 0; q < 2; ++q) { const int i = c.tid + 512 * q; *(LAS u32x4*)(ETs + (i >> 4) * 272 + (i & 15) * 16) = pe[q]; }
#pragma unroll
            for (int q = 0; q < 9; ++q) { const int i = c.tid + 512 * q; if (i < 272 * 16) *(LAS u32x4*)(Us + (i >> 4) * 272 + (i & 15) * 16) = pu[q]; }
            __syncthreads();
            if (kc + 1 < 8) S1_FETCH(kc + 1);
#pragma unroll
            for (int ks = 0; ks < 4; ++ks) {
                const bf16x8 ef = *(const LAS bf16x8*)(ETs + (16 * nbk + l15) * 272 + 64 * ks + 16 * q4);
#pragma unroll
                for (int i = 0; i < 9; ++i) { const int mb = 2 * i + mp; if (mb < 17) { const bf16x8 uf = *(const LAS bf16x8*)(Us + (16 * mb + l15) * 272 + 64 * ks + 16 * q4); acc[i] = mfma16(ef, uf, acc[i]); } }
            }
        }
#undef S1_FETCH
#pragma unroll
        for (int i = 0; i < 9; ++i) { const int mb = 2 * i + mp; if (mb < 17) *(f32x4*)(SLOC + ((size_t)dg * 272 + 16 * mb + l15) * 128 + 64 * nh + 16 * nbk + 4 * q4) = acc[i]; }
    }
    __syncthreads();
}
__device__ __forceinline__ void ssm_s2(const Ctx& c, const float* SLOC, const f32x2* LAML, bf16_t* SIN) {
    const int gt = c.bid * 512 + c.tid;
    if (gt < 2 * 64 * 4 * 64) {
        const int p = gt & 63, b = (gt >> 6) & 3, dg = gt >> 8;
        const f32x2 lm = LAML[dg * 64 + p];
        float sr = 0.f, si = 0.f;
        const f32x2* sl = (const f32x2*)(SLOC + ((size_t)dg * 272 + b * 68) * 128) + p;
        unsigned* so = (unsigned*)(SIN + ((size_t)dg * 272 + b * 68) * 128) + p;
#pragma unroll 4
        for (int k = 0; k < 68; ++k) {
            so[(size_t)k * 64] = pk2(sr, si);
            const f32x2 v = sl[(size_t)k * 64];
            const float nr = lm.x * sr - lm.y * si + v.x, ni = lm.x * si + lm.y * sr + v.y;
            sr = nr; si = ni;
        }
    }
}
__device__ __forceinline__ void ssm_s3(const Args& a, const Ctx& c, const bf16_t* H, const bf16_t* KK, const bf16_t* GT, const float* SLOC, const f32x2* LAML, bf16_t* GACT) {
    const int l15 = c.lane & 15, q4 = c.lane >> 4, w = c.wid;
    LAS unsigned char* U = c.lds;
    const float* dsk = AIN(I_SSMD);
    LAS unsigned char* SINL = c.lds + 139264;
    for (int it = c.bid; it < 64 * 8; it += c.nb) {
        const int g = it >> 3, mg = it & 7, b = mg >> 1, j0 = 32 * (mg & 1);
        __syncthreads();
        for (int i = c.tid; i < 2 * 68 * 32; i += 512) { const int d = i / (68 * 32), r = i - d * (68 * 32);
            *(LAS f32x4*)(U + (size_t)i * 16) = *(const f32x4*)(SLOC + ((size_t)(d * 64 + g) * 272 + b * 68) * 128 + (size_t)r * 4); }
        __syncthreads();
        if (c.tid < 128) { const int d = c.tid >> 6, p = c.tid & 63; const f32x2 lm = LAML[(d * 64 + g) * 64 + p];
            float sr = 0.f, si = 0.f;
            for (int k = 0; k < 68; ++k) {
                const int jj = d ? (67 - k - j0) : (k - 4 - j0);
                if (jj >= 0 && jj < 32) *(LAS unsigned*)(SINL + ((d * 32 + jj) * 128 + 2 * p) * 2) = pk2(sr, si);
                const f32x2 v = *(const LAS f32x2*)(U + ((size_t)(d * 68 + k) * 128 + 2 * p) * 4);
                const float nr = lm.x * sr - lm.y * si + v.x, ni = lm.x * si + lm.y * sr + v.y; sr = nr; si = ni; } }
        __syncthreads();
        for (int i = c.tid; i < 32 * 64 * 2; i += 512) { const int ml = i >> 7, tp = (i >> 1) & 63, hf = i & 1;
            const u32x4 v = *(const u32x4*)(H + ((size_t)g * TA + b * SEQ + 64 * (j0 + ml) + tp) * 16 + 8 * hf);
            *(LAS u32x4*)(U + ml * 2064 + (tp * 16 + 8 * hf) * 2) = v; }
        for (int i = c.tid; i < 4064; i += 512) *(LAS u32x4*)(U + 66048 + i * 16) = *(const u32x4*)(KK + (size_t)g * 127 * 256 + i * 8);
        __syncthreads();
#pragma unroll 1
        for (int par = 0; par < 2; ++par) {
            f32x4 acc[4][2];
#pragma unroll
            for (int i = 0; i < 4; ++i) { acc[i][0] = (f32x4){0.f, 0.f, 0.f, 0.f}; acc[i][1] = acc[i][0]; }
            bf16x8 ua[4], ub[4];
            const int col = 16 * g + 4 * q4; const f32x4 dv = *(const f32x4*)(dsk + col);
            u32x2 hv[4][2];
#pragma unroll
            for (int i = 0; i < 4; ++i)
#pragma unroll
                for (int mb = 0; mb < 2; ++mb) hv[i][mb] = *(const u32x2*)(H + ((size_t)g * TA + (size_t)b * SEQ + 64 * (j0 + 16 * mb + l15) + 8 * w + par + 2 * i) * 16 + 4 * q4);
            LAS unsigned char* u0 = U + l15 * 2064 + 16 * q4;
            LAS unsigned char* kbase = U + 66048 + (8 * w + par + 63 - (q4 >> 1)) * 512 + l15 * 32 + 16 * (q4 & 1);
#pragma unroll 1
            for (int e4 = 0; e4 < 36; e4 += 4) {
#pragma unroll
                for (int sft = 0; sft < 4; ++sft) {
                    const int ksn = e4 + sft, e = ksn - 3;
                    if (ksn < 32) { ua[sft] = *(const LAS bf16x8*)(u0 + 64 * ksn); ub[sft] = *(const LAS bf16x8*)(u0 + 16 * 2064 + 64 * ksn); }
                    if (e <= 31) {
                        const bf16x8 kf = *(const LAS bf16x8*)(kbase - e * 1024);
#pragma unroll
                        for (int i = 0; i < 4; ++i) { const int ks = e + i;
                            if (ks >= 0 && ks <= 31) { acc[i][0] = mfma16(kf, ua[(sft + i + 1) & 3], acc[i][0]); acc[i][1] = mfma16(kf, ub[(sft + i + 1) & 3], acc[i][1]); } }
                    }
                }
            }
            asm volatile("" ::: "memory");
            bf16x8 gA[4], gB[4];
#define S3_GT_LOAD(dst, stp) do { _Pragma("unroll") for (int i = 0; i < 4; ++i) \
                dst[i] = *(const bf16x8*)(GT + ((size_t)(((stp) >> 2) * 64 + g) * 1024 + 16 * (8 * w + par + 2 * i) + l15) * 128 + 32 * ((stp) & 3) + 8 * q4); } while (0)
#define S3_STEP(cur, stp) do { const bf16x8 s0_ = *(const LAS bf16x8*)(SINL + ((((stp) >> 2) * 32 + l15) * 128 + 32 * ((stp) & 3) + 8 * q4) * 2), s1_ = *(const LAS bf16x8*)(SINL + ((((stp) >> 2) * 32 + 16 + l15) * 128 + 32 * ((stp) & 3) + 8 * q4) * 2); \
                _Pragma("unroll") for (int i = 0; i < 4; ++i) { acc[i][0] = mfma16(cur[i], s0_, acc[i][0]); acc[i][1] = mfma16(cur[i], s1_, acc[i][1]); } } while (0)
            S3_GT_LOAD(gA, 0);
            S3_GT_LOAD(gB, 1); S3_STEP(gA, 0);
            S3_GT_LOAD(gA, 2); S3_STEP(gB, 1);
            S3_GT_LOAD(gB, 3); S3_STEP(gA, 2);
            S3_GT_LOAD(gA, 4); S3_STEP(gB, 3);
            S3_GT_LOAD(gB, 5); S3_STEP(gA, 4);
            S3_GT_LOAD(gA, 6); S3_STEP(gB, 5);
            S3_GT_LOAD(gB, 7); S3_STEP(gA, 6);
            S3_STEP(gB, 7);
#undef S3_STEP
#undef S3_GT_LOAD
#pragma unroll
            for (int i = 0; i < 4; ++i) { const int t = 8 * w + par + 2 * i;
#pragma unroll
                for (int mb = 0; mb < 2; ++mb) { const size_t row = (size_t)b * SEQ + 64 * (j0 + 16 * mb + l15) + t; const f32x4 y = acc[i][mb]; const u32x2 hq_ = hv[i][mb];
                    const float o0 = gelu_tanh(y[0] + dv[0] * bflo(hq_.x)), o1 = gelu_tanh(y[1] + dv[1] * bfhi(hq_.x)), o2 = gelu_tanh(y[2] + dv[2] * bflo(hq_.y)), o3 = gelu_tanh(y[3] + dv[3] * bfhi(hq_.y));
                    u32x2 ov; ov.x = pk2(o0, o1); ov.y = pk2(o2, o3); *(u32x2*)(GACT + row * D + col) = ov; } }
        }
    }
    __syncthreads();
}

__device__ __forceinline__ void gmlp_stats(const Ctx& c, const bf16_t* Z, float* VSTAT) {
    for (int row = c.gw; row < TL; row += c.ngw) {
        const u32x4* zr = (const u32x4*)(Z + (size_t)row * 4096 + 2048) + c.lane;
        float v[32]; float s = 0.f;
#pragma unroll
        for (int j = 0; j < 4; ++j) { const u32x4 q = zr[64 * j];
#pragma unroll
            for (int e = 0; e < 4; ++e) { v[j * 8 + 2 * e] = bflo(q[e]); v[j * 8 + 2 * e + 1] = bfhi(q[e]); s += v[j * 8 + 2 * e] + v[j * 8 + 2 * e + 1]; } }
        const float mean = wave_sum(s) * (1.f / 2048.f); float s2 = 0.f;
#pragma unroll
        for (int j = 0; j < 32; ++j) { const float dlt = v[j] - mean; s2 += dlt * dlt; }
        const float rstd = __builtin_amdgcn_rsqf(wave_sum(s2) * (1.f / 2048.f) + LN_EPS);
        if (c.lane == 0) { VSTAT[2 * row] = mean; VSTAT[2 * row + 1] = rstd; }
    }
}
__device__ __forceinline__ void gmlp_spatial(const Args& a, const Ctx& c, bf16_t* Z, const float* VSTAT, const bf16_t* WS16, bf16_t* dry = nullptr) {
    const int l15 = c.lane & 15, q4 = c.lane >> 4, w = c.wid;
    LAS bf16_t* VTL = (LAS bf16_t*)c.lds;
    const float* lg = AIN(I_GLNG); const float* lb = AIN(I_GLNB); const float* bs = AIN(I_GBS);
    u32x4 zpre[8];
#define SP_FETCH(IT) do { const int ch_ = (IT) >> 3, hh_ = (IT) & 7; _Pragma("unroll") for (int k = 0; k < 8; ++k) { const int i = c.tid + 512 * k; \
        zpre[k] = *(const u32x4*)(Z + (size_t)(ch_ * 128 + (i >> 5)) * 4096 + 2048 + 256 * hh_ + (i & 31) * 8); } } while (0)
    if (c.bid < 128 * 8) SP_FETCH(c.bid);
    for (int it = c.bid; it < 128 * 8; it += c.nb) {
        const int ch = it >> 3, hh = it & 7;
        __syncthreads();
#pragma unroll
        for (int k = 0; k < 8; ++k) { const int i = c.tid + 512 * k; const int q = i >> 5, c8 = (i & 31) * 8; const int row = ch * 128 + q;
            const u32x4 zv = zpre[k];
            const float mean = VSTAT[2 * row] * (1.f / 2048.f), rstd = __builtin_amdgcn_rsqf(fmaxf(VSTAT[2 * row + 1] * (1.f / 2048.f) - mean * mean, 0.f) + LN_EPS);
#pragma unroll
            for (int e = 0; e < 4; ++e) { const int cc = c8 + 2 * e; const int gc = 256 * hh + cc;
                const float v0 = (bflo(zv[e]) - mean) * rstd * lg[gc] + lb[gc], v1 = (bfhi(zv[e]) - mean) * rstd * lg[gc + 1] + lb[gc + 1];
                VTL[cc * 136 + q] = (bf16_t)f2bf(v0); VTL[(cc + 1) * 136 + q] = (bf16_t)f2bf(v1); } }
        __syncthreads();
        if (it + c.nb < 128 * 8) SP_FETCH(it + c.nb);
        bf16x8 WF[4];
#pragma unroll
        for (int ks = 0; ks < 4; ++ks) WF[ks] = *(const bf16x8*)(WS16 + ((size_t)hh * 128 + 16 * w + l15) * 128 + 32 * ks + 8 * q4);
        const float bsp = bs[hh * 128 + 16 * w + l15];
        const size_t row = (size_t)ch * 128 + 16 * w + l15;
        u32x2 upre[16];
#pragma unroll
        for (int cb = 0; cb < 16; ++cb) upre[cb] = *(const u32x2*)(Z + row * 4096 + 256 * hh + 16 * cb + 4 * q4);
#pragma unroll
        for (int cb = 0; cb < 16; ++cb) {
            f32x4 acc = (f32x4){0.f, 0.f, 0.f, 0.f};
#pragma unroll
            for (int ks = 0; ks < 4; ++ks) { const bf16x8 vf = *(const LAS bf16x8*)(VTL + (16 * cb + l15) * 136 + 32 * ks + 8 * q4); acc = mfma16(vf, WF[ks], acc); }
            bf16_t* up = Z + row * 4096 + 256 * hh + 16 * cb + 4 * q4;
            const u32x2 uv = upre[cb];
            u32x2 ov; ov.x = pk2(bflo(uv.x) * (acc[0] + bsp), bfhi(uv.x) * (acc[1] + bsp)); ov.y = pk2(bflo(uv.y) * (acc[2] + bsp), bfhi(uv.y) * (acc[3] + bsp));
            if (dry) *(u32x2*)(dry + row * 2048 + 256 * hh + 16 * cb + 4 * q4) = ov; else *(u32x2*)up = ov;
        }
    }
#undef SP_FETCH
    __syncthreads();
}

#define ws ((unsigned char*)kargs()->ws)
#define MODS ((float*)(ws + WS_MODS))
#define RESL ((float*)kargs()->out)
#define RESC ((float*)(ws + WS_RESC))
#define H ((bf16_t*)(ws + WS_H))
#define ABUF ((bf16_t*)(ws + WS_ABUF))
#define HID ((bf16_t*)(ws + WS_HID))
#define WUP ((bf16_t*)(ws + WS_WUP))
#define WDN ((bf16_t*)(ws + WS_WDN))
#ifndef EXPM
#define EXPM 0
#endif
#define WS_PART (WS_ABUF + (size_t)128 * 1024 * 1024)
#define GEMM_SPLITK(Eobj, Ap, Bp, K_, lda_, ldb_) do { pg8::Gemm g_{Ap, Bp, 1024, 1024 * ((K_) / 256), 256, lda_, ldb_, 256, 2, 3, 256}; pg8::StaticOrder S_; S_.init(1024, 1024 * ((K_) / 256), c.nb, c.bid); FRESH(); pg8::gemm_phase<EpiAtomic>(c.lds, g_, S_, Eobj, c.tid); } while (0)
#define FRESH() do { int t_ = threadIdx.x; asm volatile("" : "+v"(t_)); int b_ = blockIdx.x; asm volatile("" : "+s"(b_)); int n_ = gridDim.x; asm volatile("" : "+s"(n_)); c.tid = t_; c.lane = t_ & 63; c.wid = __builtin_amdgcn_readfirstlane(t_ >> 6); c.bid = b_; c.nb = n_; c.gw = b_ * 8 + c.wid; c.ngw = n_ * 8; } while (0)
#define GSYNC() do { XcdBarrier xb_; xb_.bar = (unsigned*)(ws + WS_BAR); xb_.x = xb_xcc_id(); xb_.st = (volatile LAS unsigned*)(c.lds + 135168); xcd_barrier(xb_); if (EXPM & 8) xcd_barrier(xb_); FRESH(); } while (0)
#define REP2(bit, stmt) do { stmt; if (EXPM & (bit)) { FRESH(); stmt; } } while (0)
#define GEMM(EpiT, Eobj, Ap, Bp, M_, N_, K_, lda_, ldb_, apn_) do { pg8::Gemm g_{Ap, Bp, M_, N_, K_, lda_, ldb_, apn_, 0, 0x7fffffff, 0}; pg8::StaticOrder S_; S_.init(M_, (N_), c.nb, c.bid); FRESH(); pg8::gemm_phase<EpiT>(c.lds, g_, S_, Eobj, c.tid); } while (0)

#define LNSTAT(pt) ((float*)(ws + WS_LNSTAT) + (size_t)(pt) * TL * 2)
#define LNCNT(pt) ((unsigned*)(ws + WS_LNCNT) + (size_t)(pt) * 64 * 64)
template <int layer> __device__ __forceinline__ void run_layer(const Args& a, Ctx& c) {
        const float* mods = MODS + layer * 5 * 6144;
        const int Mrows = layer < 2 ? TA : TL;
        if (layer == 0) {
            pool_mix(a, c, mods, HID);
            GSYNC();
            EpiResLn E{RESL, mods, MOD_GT1, AIN(I_LN1G) + layer * D, AIN(I_LN1B) + layer * D, H, mods, MOD_SH2, MOD_SC2, LNSTAT(0), LNCNT(0), 0, AIN(I_X), AIN(I_POOLB), AIN(I_POOLS)};
            GEMM(EpiResLn, E, HID, (const bf16_t*)(ws + WS_WPOOL), TL, 1024, 256, 1024, 256, 256);
            { EpiRes<0> Ec{AIN(I_X), AIN(I_CTX), RESL, RESC, mods, MOD_GT1, AIN(I_POOLB), AIN(I_POOLS), TL};
              GEMM(EpiRes<0>, Ec, HID + (size_t)TL * D, (const bf16_t*)(ws + WS_WPOOL), 1024, 1024, 256, 1024, 256, 256); }
            GSYNC();
            ln_pass(c, TL, TA, RESL, RESC, AIN(I_LN1G) + layer * D, AIN(I_LN1B) + layer * D, H, mods, MOD_SH2, MOD_SC2, nullptr, 0, mods, MOD_GT1);
            GSYNC();
        } else if (layer == 1) {
            EpiRope E{(bf16_t*)(ws + WS_QK), (bf16_t*)(ws + WS_VT), (const float*)(ws + WS_ROPE)};
            GEMM(EpiRope, E, H, (const bf16_t*)(ws + WS_WQKV), TA, 1536, 1024, 1024, 1024, 0);
            GSYNC();
            attn_phase(a, c, (const bf16_t*)(ws + WS_QK), (const bf16_t*)(ws + WS_VT), HID);
            GSYNC();
            EpiResLn E2{RESL, mods, MOD_GT1, AIN(I_LN1G) + layer * D, AIN(I_LN1B) + layer * D, H, mods, MOD_SH2, MOD_SC2, LNSTAT(2 * layer), LNCNT(2 * layer), 0, RESL, nullptr, nullptr};
            GEMM(EpiResLn, E2, HID, (const bf16_t*)(ws + WS_WO), TL, 1024, 1024, 1024, 1024, 0);
            { EpiAtomic Ea{(float*)(ws + WS_PART)}; GEMM_SPLITK(Ea, HID + (size_t)TL * D, (const bf16_t*)(ws + WS_WO), 1024, 1024, 1024); }
            GSYNC();
            ln_pass(c, TL, TA, RESL, RESC, AIN(I_LN1G) + layer * D, AIN(I_LN1B) + layer * D, H, mods, MOD_SH2, MOD_SC2, (const float*)(ws + WS_PART), 4, mods, MOD_GT1);
            GSYNC();
        } else if (layer == 2) {
            ssm_s1(c, H, (const bf16_t*)(ws + WS_ET), (float*)(ws + WS_SLOC));
            GSYNC();
            ssm_s3(a, c, H, (const bf16_t*)(ws + WS_KK), (const bf16_t*)(ws + WS_GT), (const float*)(ws + WS_SLOC), (const f32x2*)(ws + WS_LAML), (bf16_t*)(ws + WS_GACT));
            GSYNC();
            { EpiGluLn E{RESL, mods, MOD_GT1, AIN(I_LN1G) + layer * D, AIN(I_LN1B) + layer * D, H, mods, MOD_SH2, MOD_SC2, LNSTAT(2 * layer), LNCNT(2 * layer)};
#pragma unroll 1
              for (int r = 0; r < 2; ++r) { pg8::Gemm g_{(const bf16_t*)(ws + WS_GACT), (const bf16_t*)(ws + WS_WGLU), TL, 2048, 1024, 1024, 1024, 0, 0, 0x7fffffff, 0};
                FRESH(); pg8::StaticOrder S_; S_.init(TL, 2048, c.nb, c.bid); S_.fixed_pm = 32 * r + (c.bid >> 3); S_.fixed_pn = c.bid & 7;
                pg8::gemm_phase<EpiGluLn>(c.lds, g_, S_, E, c.tid); } }
            GSYNC();
        } else {
            conv_weight(c, AIN(I_WUP) + (size_t)layer * 1024 * F2, 1024, F2, WUP, 0);
            conv_weight(c, AIN(I_WDN) + (size_t)layer * FH * 1024, FH, 1024, WDN, 0);
            __syncthreads();
            EpiBf16<2> E{ABUF, 4096, AIN(I_GBIN), (float*)(ws + WS_VSTAT)};
            GEMM(EpiBf16<2>, E, H, (const bf16_t*)(ws + WS_WGIN), TL, 4096, 1024, 1024, 1024, 0);
            GSYNC();
            gmlp_spatial(a, c, ABUF, (const float*)(ws + WS_VSTAT), (const bf16_t*)(ws + WS_WS16));
            GSYNC();
            EpiResLn E2{RESL, mods, MOD_GT1, AIN(I_LN1G) + layer * D, AIN(I_LN1B) + layer * D, H, mods, MOD_SH2, MOD_SC2, LNSTAT(2 * layer), LNCNT(2 * layer), 0, RESL, nullptr, nullptr};
            GEMM(EpiResLn, E2, ABUF, (const bf16_t*)(ws + WS_WGOUT), TL, 1024, 2048, 4096, 2048, 0);
            GSYNC();
        }
        { EpiBf16<0> E{ABUF, F2, nullptr, nullptr}; GEMM(EpiBf16<0>, E, H, WUP, Mrows, F2, 1024, 1024, 1024, 0); }
        GSYNC();
        conv_gate(c, Mrows, ABUF, HID, AIN(I_CONVW) + (size_t)layer * 3 * F2, AIN(I_CONVB) + (size_t)layer * F2);
        GSYNC();
        { EpiResLn E{RESL, mods, MOD_GT2, AIN(I_LN2G) + layer * D, AIN(I_LN2B) + layer * D, layer < 3 ? H : (bf16_t*)nullptr, mods + 5 * 6144, MOD_SH1, MOD_SC1, LNSTAT(2 * layer + 1), LNCNT(2 * layer + 1), layer == 1 ? 1 : 0, RESL, nullptr, nullptr};
          GEMM(EpiResLn, E, HID, WDN, TL, 1024, FH, FH, FH, 0); }
        if (layer < 2) { EpiAtomic Ea{(float*)(ws + WS_PART)}; GEMM_SPLITK(Ea, HID + (size_t)TL * FH, WDN, FH, FH, FH); }
        if (layer < 3) GSYNC();
        if (layer < 2) {
            ln_pass(c, TL, TA, RESL, RESC, AIN(I_LN2G) + layer * D, AIN(I_LN2B) + layer * D, H, mods + 5 * 6144, MOD_SH1, MOD_SC1, (const float*)(ws + WS_PART), 11, mods, MOD_GT2, layer == 1 ? 1 : 0);
            conv_weight(c, AIN(I_WUP) + (size_t)(layer + 1) * 1024 * F2, 1024, F2, WUP, 0);
            conv_weight(c, AIN(I_WDN) + (size_t)(layer + 1) * FH * 1024, FH, 1024, WDN, 0);
            if (layer == 1) ssm_tables(a, c);
            GSYNC();
        }
}

__global__ void __launch_bounds__(512) hidt_fwd(Args a) {
    extern __shared__ __attribute__((aligned(16))) unsigned char lds_raw[];
    cg::grid_group grid = cg::this_grid();
    Ctx c; c.tid = threadIdx.x; c.lane = c.tid & 63; c.wid = __builtin_amdgcn_readfirstlane(c.tid >> 6); c.bid = blockIdx.x; c.nb = gridDim.x;
    c.gw = c.bid * 8 + c.wid; c.ngw = c.nb * 8; c.lds = (LAS unsigned char*)lds_raw;

    if (c.bid == 0) for (int i = c.tid; i < XCD_BAR_WORDS; i += 512) ((unsigned*)(ws + WS_BAR))[i] = 0u;
    if (c.tid < 32) ((LAS unsigned*)(c.lds + 135168))[c.tid] = 0u;
    REP2(4, phase0(a, c));
    __syncthreads();
    grid.sync();
    (void)xcd_barrier_post((unsigned*)(ws + WS_BAR), (volatile LAS unsigned*)(c.lds + 135168));
    FRESH();
    run_layer<0>(a, c);
    run_layer<1>(a, c);
    run_layer<2>(a, c);
    run_layer<3>(a, c);
}

#undef ws
#undef MODS
#undef RESL
#undef RESC
#undef H
#undef ABUF
#undef HID
#undef WUP
#undef WDN
extern "C" void kernel_launch(void* const* d_in, const int* in_sizes, int n_in, void* d_out, int out_size, void* d_ws, size_t ws_size, hipStream_t stream) {
    static int grid = 0;
    if (grid == 0) {
        if (n_in != 37 || ws_size < WS_END) { fprintf(stderr, "kernel_launch: unexpected inputs (n_in %d, ws %zu, need %zu)\n", n_in, ws_size, (size_t)WS_END); grid = -1; return; }
        int dev = 0, cus = 0, per_cu = 0;
        (void)hipGetDevice(&dev);
        (void)hipDeviceGetAttribute(&cus, hipDeviceAttributeMultiprocessorCount, dev);
        if (hipFuncSetAttribute((const void*)hidt_fwd, hipFuncAttributeMaxDynamicSharedMemorySize, LDS_BYTES) != hipSuccess) { fprintf(stderr, "kernel_launch: hipFuncSetAttribute failed\n"); grid = -1; return; }
        if (hipOccupancyMaxActiveBlocksPerMultiprocessor(&per_cu, (const void*)hidt_fwd, 512, LDS_BYTES) != hipSuccess || per_cu < 1) { fprintf(stderr, "kernel_launch: occupancy query says %d\n", per_cu); per_cu = 1; }
        (void)hipGetLastError();
        grid = cus;
    }
    if (grid < 0) return;
    Args a{};
    for (int i = 0; i < 37; ++i) a.in[i] = (const float*)d_in[i];
    a.out = (float*)d_out; a.ws = (unsigned char*)d_ws;
    void* args[] = {&a};
    hipError_t e = hipLaunchCooperativeKernel((const void*)hidt_fwd, dim3(grid), dim3(512), args, LDS_BYTES, stream);
    if (e != hipSuccess) fprintf(stderr, "cooperative launch failed: %s (grid %d)\n", hipGetErrorString(e), grid);
}
```

```cpp
#include <hip/hip_runtime.h>
#include <hip/hip_cooperative_groups.h>
#include <cstdio>
namespace cg = cooperative_groups;

#define LAS __attribute__((address_space(3)))
typedef unsigned short bf16_t;
typedef short bf16x8 __attribute__((ext_vector_type(8)));
typedef float f32x4 __attribute__((ext_vector_type(4)));
typedef float f32x2 __attribute__((ext_vector_type(2)));
typedef unsigned u32x4 __attribute__((ext_vector_type(4)));
typedef unsigned u32x2 __attribute__((ext_vector_type(2)));

constexpr int D = 1024, TL = 16384, TA = 17408, SEQ = 4096, CTXL = 256, FH = 2816, F2 = 5632;
constexpr float ALPHA = 1.681792830507429f;
constexpr float LN_EPS = 1e-5f;
constexpr int MOD_SH1 = 0, MOD_SC1 = 1024, MOD_GT1 = 2048, MOD_SH2 = 3072, MOD_SC2 = 4096, MOD_GT2 = 5120;

constexpr size_t WS_MODS = 0;
constexpr size_t WS_ROPE = 512 * 1024;
constexpr size_t WS_LAML = WS_ROPE + 16 * 1024;
constexpr size_t WS_VSTAT = WS_LAML + 128 * 1024;
constexpr size_t WS_BAR = WS_VSTAT + 128 * 1024;
constexpr size_t WS_WUP = 1024 * 1024;
constexpr size_t WS_WDN = WS_WUP + (size_t)F2 * D * 2;
constexpr size_t WS_WPOOL = WS_WDN + (size_t)D * FH * 2;
constexpr size_t WS_WQKV = WS_WPOOL + (size_t)D * 256 * 2;
constexpr size_t WS_WO = WS_WQKV + (size_t)1536 * D * 2;
constexpr size_t WS_WGLU = WS_WO + (size_t)D * D * 2;
constexpr size_t WS_WGIN = WS_WGLU + (size_t)2048 * D * 2;
constexpr size_t WS_WGOUT = WS_WGIN + (size_t)4096 * D * 2;
constexpr size_t WS_WS16 = WS_WGOUT + (size_t)D * 2048 * 2;
constexpr size_t WS_KK = WS_WS16 + (size_t)8 * 128 * 128 * 2;
constexpr size_t WS_RESC = WS_KK + (size_t)64 * 128 * 256 * 2;
constexpr size_t WS_H = WS_RESC + (size_t)1024 * D * 4;
constexpr size_t WS_ABUF = WS_H + (size_t)TA * D * 2;
constexpr size_t WS_HID = WS_ABUF + (size_t)TA * F2 * 2;
constexpr size_t WS_LNSTAT = WS_HID + (size_t)TA * FH * 2;
constexpr size_t WS_LNCNT = WS_LNSTAT + (size_t)8 * TL * 2 * 4;
constexpr size_t WS_END = WS_LNCNT + (size_t)8 * 64 * 256;
constexpr size_t WS_QK = WS_ABUF;
constexpr size_t WS_VT = WS_ABUF + (size_t)TA * 1280 * 2;
constexpr size_t WS_ET = WS_ABUF;
constexpr size_t WS_GT = WS_ABUF + (size_t)2 * 64 * 128 * 1024 * 2;
constexpr size_t WS_SLOC = WS_HID;
constexpr size_t WS_SIN = WS_HID + (size_t)2 * 64 * 272 * 128 * 4;
constexpr size_t WS_GACT = WS_SIN + (size_t)2 * 64 * 272 * 128 * 2;
static_assert(WS_GACT + (size_t)TL * D * 2 <= WS_END, "ws map");

constexpr int LDS_BYTES = 163840;

__device__ __forceinline__ unsigned f2bf(float f) { unsigned u = __builtin_bit_cast(unsigned, f); return (u + 0x7fffu + ((u >> 16) & 1u)) >> 16; }
__device__ __forceinline__ unsigned pk2(float lo, float hi) { typedef float f2_t __attribute__((ext_vector_type(2))); typedef __bf16 b2_t __attribute__((ext_vector_type(2))); f2_t v = {lo, hi}; b2_t b = __builtin_convertvector(v, b2_t); return __builtin_bit_cast(unsigned, b); }
__device__ __forceinline__ float bflo(unsigned w) { return __builtin_bit_cast(float, w << 16); }
__device__ __forceinline__ float bfhi(unsigned w) { return __builtin_bit_cast(float, w & 0xffff0000u); }
__device__ __forceinline__ float sigmoidf_(float x) { return __builtin_amdgcn_rcpf(1.0f + __expf(-x)); }
__device__ __forceinline__ float siluf_(float x) { return x * __builtin_amdgcn_rcpf(1.0f + __expf(-x)); }
__device__ __forceinline__ float gelu_tanh(float x) { const float u = 0.7978845608028654f * (x + 0.044715f * x * x * x); return x * __builtin_amdgcn_rcpf(1.0f + __expf(-2.0f * u)); }
__device__ __forceinline__ float wave_sum(float v) {
#pragma unroll
    for (int o = 1; o < 64; o <<= 1) v += __shfl_xor(v, o);
    return v;
}
#define LDS_WAIT() asm volatile("s_waitcnt lgkmcnt(0)" ::: "memory")
__device__ __forceinline__ f32x4 mfma16(bf16x8 a, bf16x8 b, f32x4 c) { return __builtin_amdgcn_mfma_f32_16x16x32_bf16(a, b, c, 0, 0, 0); }

namespace pg8 {
constexpr int BM = 256, BK = 64, HALF = 128, HTB = HALF * BK * 2, STAGE_BYTES = 8 * HTB, NXCD = 8, WGM = 8;
__host__ __device__ __forceinline__ int lds_byte(int r, int c) { const int st = (r >> 4) * 2 + (c >> 5), rr = r & 15, cc = c & 31, ob = rr * 64 + cc * 2; return st * 1024 + (ob ^ (((ob >> 9) & 1) << 5)); }
__host__ __device__ __forceinline__ void stage_rc(int b, int& R, int& C) { const int st = b / 1024, sb = b % 1024, swz = sb ^ (((sb >> 9) & 1) << 5); R = (st >> 1) * 16 + swz / 64; C = (st & 1) * 32 + (swz % 64) / 2; }
__host__ __device__ __forceinline__ int perm32(int rho) { const int n = rho >> 4, i = rho & 15; return 8 * (i >> 2) + 4 * n + (i & 3); }
struct Unit { int pm, pn; };
struct Gemm { const bf16_t* A; const bf16_t* Bt; int M, N, K, lda, ldb, apn, pshift, pmask, bpn; };
struct StaticOrder {
    int nM, nN, nwg, G, c, fixed_pm, fixed_pn;
    __device__ void init(int M, int N, int G_, int c_) { nM = M / BM; nN = N / BM; nwg = nM * nN; G = G_; c = c_; fixed_pm = -1; fixed_pn = 0; }
    __device__ bool next(int i, Unit& u) const {
        if (fixed_pm >= 0) { if (i > 0) return false; u.pm = fixed_pm; u.pn = fixed_pn; return true; }
        const long L = (long)i * G + c; if (L >= nwg) return false;
        int wgid = (int)L; { const int q = nwg / NXCD, r = nwg % NXCD, xcd = wgid % NXCD, off = wgid / NXCD; wgid = (xcd < r ? xcd * (q + 1) : r * (q + 1) + (xcd - r) * q) + off; }
        const int nig = WGM * nN, gid = wgid / nig, fm = gid * WGM, gsz = (nM - fm) < WGM ? (nM - fm) : WGM;
        u.pm = fm + ((wgid % nig) % gsz); u.pn = (wgid % nig) / gsz; return true;
    }
};
__device__ __forceinline__ unsigned cvt_pk_bf16(float lo, float hi) { unsigned r; asm volatile("v_cvt_pk_bf16_f32 %0, %1, %2" : "=v"(r) : "v"(lo), "v"(hi)); return r; }

template <class Epi>
__device__ __forceinline__ void gemm_phase(LAS unsigned char* lds, const Gemm g, const StaticOrder& S, const Epi& E, const int tid) {
    const int wid = __builtin_amdgcn_readfirstlane(tid >> 6), lane = tid & 63, wr = wid >> 2, wc = wid & 3, fr = lane & 15, fq = lane >> 4;
    const int K = g.K, nt = K / BK;
    unsigned voffA[2], voffB[2];
#pragma unroll
    for (int i = 0; i < 2; ++i) { int R, C; stage_rc(tid * 16 + i * 8192, R, C); const int Rb = Epi::PERM ? ((R & ~31) + perm32(R & 31)) : R;
        voffA[i] = (unsigned)(R * g.lda + C) * 2u; voffB[i] = (unsigned)(Rb * g.ldb + C) * 2u; }
    const size_t kstep = (size_t)(BK * 2);
    const size_t hstepA = (size_t)HALF * g.lda * 2, hstepB = (size_t)HALF * g.ldb * 2;
    const unsigned ldsw = (unsigned)wid * 1024u;
    const int aoff = lds_byte(wr * 64 + fr, fq * 8), boff = lds_byte(wc * 32 + fr, fq * 8);
#define PG8_SA(b, h) (((b) * 2 + (h)) * HTB)
#define PG8_SB(b, h) ((4 + (b) * 2 + (h)) * HTB)
#define PG8_STAGE(bufoff, gbase, voff) do { _Pragma("unroll") for (int _i = 0; _i < 2; ++_i) \
        __builtin_amdgcn_global_load_lds((const unsigned*)((const char*)(gbase) + (voff)[_i]), (LAS unsigned*)(lds + (bufoff) + ldsw + _i * 8192), 16, 0, 0); } while (0)
#define PG8_LDA(dst, b, h) do { _Pragma("unroll") for (int m = 0; m < 4; ++m) _Pragma("unroll") for (int k = 0; k < 2; ++k) dst[m][k] = *(const LAS bf16x8*)(lds + PG8_SA(b, h) + aoff + m * 2048 + k * 1024); } while (0)
#define PG8_LDB(dst, b, h) do { _Pragma("unroll") for (int n = 0; n < 2; ++n) _Pragma("unroll") for (int k = 0; k < 2; ++k) dst[n][k] = *(const LAS bf16x8*)(lds + PG8_SB(b, h) + boff + n * 2048 + k * 1024); } while (0)
#define PG8_MMA(ai, bj, At, Bt) do { __builtin_amdgcn_s_setprio(1); _Pragma("unroll") for (int m = 0; m < 4; ++m) _Pragma("unroll") for (int n = 0; n < 2; ++n) _Pragma("unroll") for (int k = 0; k < 2; ++k) \
        acc[ai][bj][m][n] = __builtin_amdgcn_mfma_f32_16x16x32_bf16(Bt[n][k], At[m][k], acc[ai][bj][m][n], 0, 0, 0); __builtin_amdgcn_s_setprio(0); } while (0)
#define PG8_WAIT_V(n) asm volatile("s_waitcnt vmcnt(" #n ")" ::: "memory")
#define PG8_WAIT_L(n) asm volatile("s_waitcnt lgkmcnt(" #n ")" ::: "memory")
#define PG8_BAR __builtin_amdgcn_s_barrier()
#define PG8_SCHED __builtin_amdgcn_sched_barrier(0)
    Unit cur, nxt; int ui = 0;
    if (!S.next(0, cur)) return;
    f32x4 acc[2][2][4][2];
#pragma unroll
    for (int a = 0; a < 2; ++a)
#pragma unroll
        for (int b = 0; b < 2; ++b)
#pragma unroll
            for (int m = 0; m < 4; ++m)
#pragma unroll
                for (int n = 0; n < 2; ++n) acc[a][b][m][n] = (f32x4){0.f, 0.f, 0.f, 0.f};
    bf16x8 At[4][2], B0[2][2], B1[2][2];
    const char* cA = (const char*)g.A + (size_t)cur.pm * 2 * hstepA + (size_t)(cur.pn >> g.pshift) * g.apn * 2; const char* cB = (const char*)g.Bt + (size_t)(cur.pn & g.pmask) * 2 * hstepB + (size_t)(cur.pn >> g.pshift) * g.bpn * 2;
    PG8_STAGE(PG8_SB(0, 0), cB, voffB); PG8_STAGE(PG8_SA(0, 0), cA, voffA); PG8_STAGE(PG8_SB(0, 1), cB + hstepB, voffB); PG8_STAGE(PG8_SA(0, 1), cA + hstepA, voffA);
    if (wr == 1) PG8_BAR;
    PG8_WAIT_V(4); PG8_BAR;
    PG8_STAGE(PG8_SB(1, 0), cB + kstep, voffB); PG8_STAGE(PG8_SA(1, 0), cA + kstep, voffA); PG8_STAGE(PG8_SB(1, 1), cB + hstepB + kstep, voffB);
    PG8_WAIT_V(6); PG8_BAR;
    for (;;) {
        const bool has_next = S.next(ui + 1, nxt);
        const char* nA = has_next ? (const char*)g.A + (size_t)nxt.pm * 2 * hstepA + (size_t)(nxt.pn >> g.pshift) * g.apn * 2 : cA; const char* nB = has_next ? (const char*)g.Bt + (size_t)(nxt.pn & g.pmask) * 2 * hstepB + (size_t)(nxt.pn >> g.pshift) * g.bpn * 2 : cB;
        for (int t = 0; t < nt; t += 2) {
            const bool last = (t == nt - 2);
            const char* a1 = cA + (size_t)(t + 1) * kstep;
            const char* a2 = last ? nA : cA + (size_t)(t + 2) * kstep; const char* b2 = last ? nB : cB + (size_t)(t + 2) * kstep;
            const char* a3 = a2 + kstep; const char* b3 = b2 + kstep;
            PG8_LDB(B0, 0, 0); PG8_SCHED; PG8_LDA(At, 0, 0); PG8_STAGE(PG8_SA(1, 1), a1 + hstepA, voffA);
            PG8_WAIT_L(8); PG8_BAR; PG8_WAIT_L(0); PG8_MMA(0, 0, At, B0); PG8_BAR; PG8_SCHED;
            PG8_LDB(B1, 0, 1); PG8_STAGE(PG8_SB(0, 0), b2, voffB);
            PG8_BAR; PG8_WAIT_L(0); PG8_MMA(0, 1, At, B1); PG8_BAR;
            PG8_LDA(At, 0, 1); PG8_STAGE(PG8_SA(0, 0), a2, voffA);
            PG8_BAR; PG8_WAIT_L(0); PG8_MMA(1, 0, At, B0); PG8_BAR; PG8_SCHED;
            PG8_STAGE(PG8_SB(0, 1), b2 + hstepB, voffB);
            PG8_WAIT_V(6); PG8_BAR; PG8_MMA(1, 1, At, B1); PG8_BAR;
            PG8_LDB(B0, 1, 0); PG8_SCHED; PG8_LDA(At, 1, 0); PG8_STAGE(PG8_SA(0, 1), a2 + hstepA, voffA);
            PG8_WAIT_L(8); PG8_BAR; PG8_WAIT_L(0); PG8_MMA(0, 0, At, B0); PG8_BAR; PG8_SCHED;
            PG8_LDB(B1, 1, 1); PG8_STAGE(PG8_SB(1, 0), b3, voffB);
            PG8_BAR; PG8_WAIT_L(0); PG8_MMA(0, 1, At, B1); PG8_BAR;
            PG8_LDA(At, 1, 1); PG8_STAGE(PG8_SA(1, 0), a3, voffA);
            PG8_BAR; PG8_WAIT_L(0); PG8_MMA(1, 0, At, B0); PG8_BAR; PG8_SCHED;
            PG8_STAGE(PG8_SB(1, 1), b3 + hstepB, voffB);
            PG8_WAIT_V(6); PG8_BAR; PG8_MMA(1, 1, At, B1); PG8_BAR;
        }
        if constexpr (!Epi::AFTER_DRAIN) E(acc, cur, wr, wc, fr, fq);
        if (!has_next) break;
#pragma unroll
        for (int a = 0; a < 2; ++a)
#pragma unroll
            for (int b = 0; b < 2; ++b)
#pragma unroll
                for (int m = 0; m < 4; ++m)
#pragma unroll
                    for (int n = 0; n < 2; ++n) acc[a][b][m][n] = (f32x4){0.f, 0.f, 0.f, 0.f};
        cur = nxt; cA = nA; cB = nB; ++ui;
    }
    PG8_WAIT_V(0);
    if (wr == 0) PG8_BAR;
    PG8_BAR;
    if constexpr (Epi::AFTER_DRAIN) E.fused(acc, cur, wr, wc, fr, fq, lds, tid);
#undef PG8_SA
#undef PG8_SB
#undef PG8_STAGE
#undef PG8_LDA
#undef PG8_LDB
#undef PG8_MMA
#undef PG8_WAIT_V
#undef PG8_WAIT_L
#undef PG8_BAR
#undef PG8_SCHED
}
}

template <int ACT  > struct EpiBf16 {
    static constexpr bool PERM = true, AFTER_DRAIN = false;
    bf16_t* O; int ldc; const float* bias; float* stat;
    __device__ __forceinline__ void operator()(const f32x4 (&acc)[2][2][4][2], const pg8::Unit& u, int wr, int wc, int fr, int fq) const {
        asm volatile("" : "+v"(fr), "+v"(fq));
        const int row0 = u.pm * 256 + wr * 64 + fr, col0 = u.pn * 256 + wc * 32 + 8 * fq;
#pragma unroll
        for (int ai = 0; ai < 2; ++ai)
#pragma unroll
            for (int m = 0; m < 4; ++m) { bf16_t* rowp = O + (size_t)(row0 + ai * 128 + m * 16) * ldc + col0;
                float ssum = 0.f, ssq = 0.f;
#pragma unroll
                for (int bj = 0; bj < 2; ++bj) { f32x4 v0 = acc[ai][bj][m][0], v1 = acc[ai][bj][m][1];
                    if (ACT >= 1) { const f32x4 b0 = *(const f32x4*)(bias + col0 + bj * 128), b1 = *(const f32x4*)(bias + col0 + bj * 128 + 4);
#pragma unroll
                        for (int j = 0; j < 4; ++j) { v0[j] = gelu_tanh(v0[j] + b0[j]); v1[j] = gelu_tanh(v1[j] + b1[j]); } }
                    u32x4 w; w.x = pg8::cvt_pk_bf16(v0[0], v0[1]); w.y = pg8::cvt_pk_bf16(v0[2], v0[3]); w.z = pg8::cvt_pk_bf16(v1[0], v1[1]); w.w = pg8::cvt_pk_bf16(v1[2], v1[3]);
                    if (ACT == 2) {
#pragma unroll
                        for (int j = 0; j < 4; ++j) { ssum += v0[j] + v1[j]; ssq += v0[j] * v0[j] + v1[j] * v1[j]; } }
                    *(u32x4*)(rowp + bj * 128) = w; }
                if (ACT == 2 && u.pn >= 8) { ssum += __shfl_xor(ssum, 16); ssum += __shfl_xor(ssum, 32); ssq += __shfl_xor(ssq, 16); ssq += __shfl_xor(ssq, 32);
                    if (fq == 0) { float* sp = stat + 2 * (size_t)(row0 + ai * 128 + m * 16);
                        (void)__hip_atomic_fetch_add(sp, ssum, __ATOMIC_RELAXED, __HIP_MEMORY_SCOPE_AGENT); (void)__hip_atomic_fetch_add(sp + 1, ssq, __ATOMIC_RELAXED, __HIP_MEMORY_SCOPE_AGENT); } } }
    }
};
template <int GLU> struct EpiRes {
    static constexpr bool PERM = false, AFTER_DRAIN = false;
    const float* xin_lat; const float* xin_ctx; float* out_lat; float* out_ctx; const float* mods; int gate_off; const float* bias; const float* scale; int row_base;
    __device__ __forceinline__ void operator()(const f32x4 (&acc)[2][2][4][2], const pg8::Unit& u, int wr, int wc, int fr, int fq) const {
        asm volatile("" : "+v"(fr), "+v"(fq));
        const int rowt = u.pm * 256 + row_base; const bool isctx = rowt >= TL; const int cond = isctx ? 4 : (rowt >> 12);
        const float* gate = mods + cond * 6144 + gate_off;
        const float* xi = isctx ? xin_ctx + (size_t)(rowt - TL) * D : xin_lat + (size_t)rowt * D;
        float* xo = isctx ? out_ctx + (size_t)(rowt - TL) * D : out_lat + (size_t)rowt * D;
        const int rl0 = wr * 64 + fr;
        if (GLU) {
            const int col0 = u.pn * 128 + wc * 32 + 4 * fq;
#pragma unroll
            for (int n = 0; n < 2; ++n) { const f32x4 g4 = *(const f32x4*)(gate + col0 + n * 16);
                f32x4 xv[8];
#pragma unroll
                for (int q = 0; q < 8; ++q) xv[q] = *(const f32x4*)(xi + (size_t)(rl0 + (q >> 2) * 128 + (q & 3) * 16) * D + col0 + n * 16);
#pragma unroll
                for (int q = 0; q < 8; ++q) { const int ai = q >> 2, m = q & 3; const size_t o = (size_t)(rl0 + ai * 128 + m * 16) * D + col0 + n * 16;
                    const f32x4 a = acc[ai][0][m][n], b = acc[ai][1][m][n]; f32x4 v;
#pragma unroll
                    for (int j = 0; j < 4; ++j) v[j] = ALPHA * xv[q][j] + g4[j] * (a[j] * sigmoidf_(b[j]));
                    *(f32x4*)(xo + o) = v; } }
        } else {
            const int col0 = u.pn * 256 + wc * 32 + 4 * fq;
#pragma unroll
            for (int bj = 0; bj < 2; ++bj)
#pragma unroll
                for (int n = 0; n < 2; ++n) { const int c = col0 + bj * 128 + n * 16; const f32x4 g4 = *(const f32x4*)(gate + c);
                    f32x4 b4 = (f32x4){0.f, 0.f, 0.f, 0.f}, s4 = (f32x4){1.f, 1.f, 1.f, 1.f};
                    if (bias) { b4 = *(const f32x4*)(bias + c); s4 = *(const f32x4*)(scale + c); }
#pragma unroll
                    for (int hb = 0; hb < 2; ++hb) {
                        f32x4 xv[4];
#pragma unroll
                        for (int q = 0; q < 4; ++q) xv[q] = *(const f32x4*)(xi + (unsigned)(rl0 + hb * 128 + q * 16) * (unsigned)D + (unsigned)c);
                        __builtin_amdgcn_sched_barrier(0);
#pragma unroll
                        for (int q = 0; q < 4; ++q) { const f32x4 a = acc[hb][bj][q][n]; f32x4 v;
#pragma unroll
                            for (int j = 0; j < 4; ++j) v[j] = ALPHA * xv[q][j] + g4[j] * ((a[j] + b4[j]) * s4[j]);
                            *(f32x4*)(xo + (unsigned)(rl0 + hb * 128 + q * 16) * (unsigned)D + (unsigned)c) = v; }
                        asm volatile("" ::: "memory"); __builtin_amdgcn_sched_barrier(0); } }
        }
    }
};
struct EpiResLn {
    static constexpr bool PERM = false, AFTER_DRAIN = true;
    float* res; const float* mods; int gate_off; const float* lng; const float* lnb; bf16_t* Hout; const float* hmods; int sh_off, sc_off; float* stat; unsigned* cnt;
    int hgm;
    const float* xin; const float* bias; const float* scale;
    __device__ __forceinline__ void prefetch(const pg8::Unit& u, int tid, int wid, LAS unsigned char* lds) const {
        const int upm = __builtin_amdgcn_readfirstlane(u.pm), upn = __builtin_amdgcn_readfirstlane(u.pn);
        const float* base = xin + (size_t)upm * 256 * D + upn * 256;
#pragma unroll
        for (int k = 0; k < 4; ++k) { const int q = tid + 512 * k;
            __builtin_amdgcn_global_load_lds((const unsigned*)(base + (size_t)(q >> 3) * D + (q & 7) * 32), (LAS unsigned*)(lds + 157696 + wid * 256), 4, 0, 0); }
    }
    __device__ __forceinline__ void operator()(const f32x4 (&)[2][2][4][2], const pg8::Unit&, int, int, int, int) const {}
    __device__ __forceinline__ void fused(f32x4 (&acc)[2][2][4][2], const pg8::Unit& u, int wr, int wc, int fr, int fq, LAS unsigned char* lds, int tid) const {
        const int upm = __builtin_amdgcn_readfirstlane(u.pm), upn = __builtin_amdgcn_readfirstlane(u.pn);
        const int rowt = upm * 256, cond = rowt >> 12;
        const float* gate = mods + cond * 6144 + gate_off;
        float* xo = res + (size_t)rowt * D; bf16_t* ho = Hout + (size_t)rowt * D; const float* xi = xin + (size_t)rowt * D;
        const int rl0 = wr * 64 + fr, col0 = upn * 256 + wc * 32 + 4 * fq;
        LAS f32x2* P = (LAS f32x2*)lds;
        LAS f32x2* S = (LAS f32x2*)(lds + 8192);
#pragma unroll
        for (int bj = 0; bj < 2; ++bj)
#pragma unroll
            for (int n = 0; n < 2; ++n) { const int c = col0 + bj * 128 + n * 16; const f32x4 g4 = *(const f32x4*)(gate + c);
                f32x4 b4 = (f32x4){0.f, 0.f, 0.f, 0.f}, s4 = (f32x4){1.f, 1.f, 1.f, 1.f};
                if (bias) { b4 = *(const f32x4*)(bias + c); s4 = *(const f32x4*)(scale + c); }
#pragma unroll
                for (int hb = 0; hb < 2; ++hb) {
                    f32x4 xv[4];
#pragma unroll
                    for (int q = 0; q < 4; ++q) { const unsigned o = (unsigned)(rl0 + hb * 128 + q * 16) * (unsigned)D + (unsigned)c; xv[q] = *(const f32x4*)(xi + o); }
                    __builtin_amdgcn_sched_barrier(0);
#pragma unroll
                    for (int q = 0; q < 4; ++q) { acc[hb][bj][q][n] = ALPHA * xv[q] + g4 * ((acc[hb][bj][q][n] + b4) * s4); asm volatile("" : "+v"(acc[hb][bj][q][n])); }
                    asm volatile("" ::: "memory"); __builtin_amdgcn_sched_barrier(0); } }
#pragma unroll
        for (int ai = 0; ai < 2; ++ai)
#pragma unroll
            for (int m = 0; m < 4; ++m) { float s = 0.f, q = 0.f;
#pragma unroll
                for (int bj = 0; bj < 2; ++bj)
#pragma unroll
                    for (int n = 0; n < 2; ++n) { const f32x4 x = acc[ai][bj][m][n]; s += (x[0] + x[1]) + (x[2] + x[3]); q += (x[0] * x[0] + x[1] * x[1]) + (x[2] * x[2] + x[3] * x[3]); }
                s += __shfl_xor(s, 16); s += __shfl_xor(s, 32); q += __shfl_xor(q, 16); q += __shfl_xor(q, 32);
                if (fq == 0) P[(ai * 128 + wr * 64 + m * 16 + fr) * 4 + wc] = (f32x2){s, q}; }
        LDS_WAIT(); __syncthreads();
        if (tid < 256) { const f32x2 a = P[tid * 4 + 0], b = P[tid * 4 + 1], c2 = P[tid * 4 + 2], d = P[tid * 4 + 3];
            float* sp = stat + 2 * (size_t)(rowt + tid);
            const float r0 = __hip_atomic_fetch_add(sp, (a.x + b.x) + (c2.x + d.x), __ATOMIC_RELAXED, __HIP_MEMORY_SCOPE_AGENT);
            const float r1 = __hip_atomic_fetch_add(sp + 1, (a.y + b.y) + (c2.y + d.y), __ATOMIC_RELAXED, __HIP_MEMORY_SCOPE_AGENT);
            asm volatile("" :: "v"(r0), "v"(r1)); }
        asm volatile("s_waitcnt vmcnt(0)" ::: "memory");
        __syncthreads();
        if (tid == 0) { unsigned* cp = cnt + 64 * upm;
            (void)__hip_atomic_fetch_add(cp, 1u, __ATOMIC_RELAXED, __HIP_MEMORY_SCOPE_AGENT);
            unsigned sp_ = 0;
            while (__hip_atomic_load(cp, __ATOMIC_RELAXED, __HIP_MEMORY_SCOPE_AGENT) < 4u) { __builtin_amdgcn_s_sleep(2); if (++sp_ > (1u << 22)) break; } }
        __syncthreads();
        if (tid < 256) { const float* sp = stat + 2 * (size_t)(rowt + tid);
            const float s = __hip_atomic_load(sp, __ATOMIC_RELAXED, __HIP_MEMORY_SCOPE_AGENT), q = __hip_atomic_load(sp + 1, __ATOMIC_RELAXED, __HIP_MEMORY_SCOPE_AGENT);
            const float mean = s * (1.f / D), var = fmaxf(q * (1.f / D) - mean * mean, 0.f);
            S[tid] = (f32x2){mean, __builtin_amdgcn_rsqf(var + LN_EPS)}; }
        LDS_WAIT(); __syncthreads();
#pragma unroll
        for (int bj = 0; bj < 2; ++bj)
#pragma unroll
            for (int n = 0; n < 2; ++n) { const int c = col0 + bj * 128 + n * 16; const f32x4 lg4 = *(const f32x4*)(lng + c), lb4 = *(const f32x4*)(lnb + c);
                f32x4 sh4 = (f32x4){0.f, 0.f, 0.f, 0.f}, sc4 = sh4;
                if (Hout) { sh4 = *(const f32x4*)(hmods + cond * 6144 + sh_off + c); sc4 = 1.0f + *(const f32x4*)(hmods + cond * 6144 + sc_off + c); }
#pragma unroll
                for (int q = 0; q < 8; ++q) { const int ai = q >> 2, m = q & 3; const unsigned o = (unsigned)(rl0 + ai * 128 + m * 16) * (unsigned)D + (unsigned)c;
                    const f32x2 stq = S[ai * 128 + wr * 64 + m * 16 + fr];
                    const f32x4 x = (acc[ai][bj][m][n] - stq.x) * stq.y * lg4 + lb4;
                    *(f32x4*)(xo + o) = x;
                    if (Hout) { const f32x4 h = x * sc4 + sh4; u32x2 w; w.x = pk2(h[0], h[1]); w.y = pk2(h[2], h[3]);
                        if (hgm) *(u32x2*)(Hout + ((size_t)(c >> 4) * TA + rowt + rl0 + ai * 128 + m * 16) * 16 + (c & 15)) = w; else *(u32x2*)(ho + o) = w; } }
                asm volatile("" ::: "memory"); __builtin_amdgcn_sched_barrier(0); }
        LDS_WAIT(); __syncthreads();
    }
};
struct EpiGluLn {
    static constexpr bool PERM = false, AFTER_DRAIN = true;
    float* res; const float* mods; int gate_off; const float* lng; const float* lnb; bf16_t* Hout; const float* hmods; int sh_off, sc_off; float* stat; unsigned* cnt;
    __device__ __forceinline__ void prefetch(const pg8::Unit& u, int tid, int wid, LAS unsigned char* lds) const {
        const int upm = __builtin_amdgcn_readfirstlane(u.pm), upn = __builtin_amdgcn_readfirstlane(u.pn);
        const float* base = res + (size_t)upm * 256 * D + upn * 128;
#pragma unroll
        for (int k = 0; k < 2; ++k) { const int q = tid + 512 * k;
            __builtin_amdgcn_global_load_lds((const unsigned*)(base + (size_t)(q >> 2) * D + (q & 3) * 32), (LAS unsigned*)(lds + 157696 + wid * 256), 4, 0, 0); }
    }
    __device__ __forceinline__ void operator()(const f32x4 (&)[2][2][4][2], const pg8::Unit&, int, int, int, int) const {}
    __device__ __forceinline__ void fused(f32x4 (&acc)[2][2][4][2], const pg8::Unit& u, int wr, int wc, int fr, int fq, LAS unsigned char* lds, int tid) const {
        const int upm = __builtin_amdgcn_readfirstlane(u.pm), upn = __builtin_amdgcn_readfirstlane(u.pn);
        const int rowt = upm * 256, cond = rowt >> 12;
        const float* gate = mods + cond * 6144 + gate_off;
        float* xo = res + (size_t)rowt * D; bf16_t* ho = Hout + (size_t)rowt * D;
        const int rl0 = wr * 64 + fr, col0 = upn * 128 + wc * 32 + 4 * fq;
        LAS f32x2* P = (LAS f32x2*)lds; LAS f32x2* S = (LAS f32x2*)(lds + 8192);
#pragma unroll
        for (int n = 0; n < 2; ++n) { const int c = col0 + n * 16; const f32x4 g4 = *(const f32x4*)(gate + c);
#pragma unroll
            for (int hb = 0; hb < 2; ++hb) {
                f32x4 xv[4];
#pragma unroll
                for (int q = 0; q < 4; ++q) { const unsigned o = (unsigned)(rl0 + hb * 128 + q * 16) * (unsigned)D + (unsigned)c; xv[q] = *(const f32x4*)(xo + o); }
                __builtin_amdgcn_sched_barrier(0);
#pragma unroll
                for (int q = 0; q < 4; ++q) { const f32x4 a = acc[hb][0][q][n], b = acc[hb][1][q][n]; f32x4 v;
#pragma unroll
                    for (int j = 0; j < 4; ++j) v[j] = ALPHA * xv[q][j] + g4[j] * (a[j] * sigmoidf_(b[j]));
                    acc[hb][0][q][n] = v; asm volatile("" : "+v"(acc[hb][0][q][n])); }
                asm volatile("" ::: "memory"); __builtin_amdgcn_sched_barrier(0); } }
#pragma unroll
        for (int ai = 0; ai < 2; ++ai)
#pragma unroll
            for (int m = 0; m < 4; ++m) { float s = 0.f, q = 0.f;
#pragma unroll
                for (int n = 0; n < 2; ++n) { const f32x4 x = acc[ai][0][m][n]; s += (x[0] + x[1]) + (x[2] + x[3]); q += (x[0] * x[0] + x[1] * x[1]) + (x[2] * x[2] + x[3] * x[3]); }
                s += __shfl_xor(s, 16); s += __shfl_xor(s, 32); q += __shfl_xor(q, 16); q += __shfl_xor(q, 32);
                if (fq == 0) P[(ai * 128 + wr * 64 + m * 16 + fr) * 4 + wc] = (f32x2){s, q}; }
        LDS_WAIT(); __syncthreads();
        if (tid < 256) { const f32x2 a = P[tid * 4 + 0], b = P[tid * 4 + 1], c2 = P[tid * 4 + 2], d = P[tid * 4 + 3];
            float* sp = stat + 2 * (size_t)(rowt + tid);
            const float r0 = __hip_atomic_fetch_add(sp, (a.x + b.x) + (c2.x + d.x), __ATOMIC_RELAXED, __HIP_MEMORY_SCOPE_AGENT);
            const float r1 = __hip_atomic_fetch_add(sp + 1, (a.y + b.y) + (c2.y + d.y), __ATOMIC_RELAXED, __HIP_MEMORY_SCOPE_AGENT);
            asm volatile("" :: "v"(r0), "v"(r1)); }
        asm volatile("s_waitcnt vmcnt(0)" ::: "memory");
        __syncthreads();
        if (tid == 0) { unsigned* cp = cnt + 64 * upm;
            (void)__hip_atomic_fetch_add(cp, 1u, __ATOMIC_RELAXED, __HIP_MEMORY_SCOPE_AGENT);
            unsigned sp_ = 0;
            while (__hip_atomic_load(cp, __ATOMIC_RELAXED, __HIP_MEMORY_SCOPE_AGENT) < 8u) { __builtin_amdgcn_s_sleep(2); if (++sp_ > (1u << 22)) break; } }
        __syncthreads();
        if (tid < 256) { const float* sp = stat + 2 * (size_t)(rowt + tid);
            const float s = __hip_atomic_load(sp, __ATOMIC_RELAXED, __HIP_MEMORY_SCOPE_AGENT), q = __hip_atomic_load(sp + 1, __ATOMIC_RELAXED, __HIP_MEMORY_SCOPE_AGENT);
            const float mean = s * (1.f / D), var = fmaxf(q * (1.f / D) - mean * mean, 0.f);
            S[tid] = (f32x2){mean, __builtin_amdgcn_rsqf(var + LN_EPS)}; }
        LDS_WAIT(); __syncthreads();
#pragma unroll
        for (int n = 0; n < 2; ++n) { const int c = col0 + n * 16; const f32x4 lg4 = *(const f32x4*)(lng + c), lb4 = *(const f32x4*)(lnb + c);
            const f32x4 sh4 = *(const f32x4*)(hmods + cond * 6144 + sh_off + c), sc4 = 1.0f + *(const f32x4*)(hmods + cond * 6144 + sc_off + c);
#pragma unroll
            for (int q = 0; q < 8; ++q) { const int ai = q >> 2, m = q & 3; const unsigned o = (unsigned)(rl0 + ai * 128 + m * 16) * (unsigned)D + (unsigned)c;
                const f32x2 stq = S[ai * 128 + wr * 64 + m * 16 + fr];
                const f32x4 x = (acc[ai][0][m][n] - stq.x) * stq.y * lg4 + lb4;
                *(f32x4*)(xo + o) = x;
                const f32x4 h = x * sc4 + sh4; u32x2 w; w.x = pk2(h[0], h[1]); w.y = pk2(h[2], h[3]); *(u32x2*)(ho + o) = w; }
            asm volatile("" ::: "memory"); __builtin_amdgcn_sched_barrier(0); }
        LDS_WAIT(); __syncthreads();
    }
};
struct EpiAtomic {
    static constexpr bool PERM = false, AFTER_DRAIN = false;
    float* part;
    __device__ __forceinline__ void operator()(const f32x4 (&acc)[2][2][4][2], const pg8::Unit& u, int wr, int wc, int fr, int fq) const {
        asm volatile("" : "+v"(fr), "+v"(fq));
        const int row0 = u.pm * 256 + wr * 64 + fr, col0 = (u.pn & 3) * 256 + wc * 32 + 4 * fq;
        float* base = part + (size_t)(u.pn >> 2) * 1024 * 1024;
#pragma unroll
        for (int ai = 0; ai < 2; ++ai)
#pragma unroll
            for (int m = 0; m < 4; ++m) { float* o = base + (size_t)(row0 + ai * 128 + m * 16) * D + col0;
#pragma unroll
                for (int bj = 0; bj < 2; ++bj)
#pragma unroll
                    for (int n = 0; n < 2; ++n) *(f32x4*)(o + bj * 128 + n * 16) = acc[ai][bj][m][n]; }
    }
};
struct EpiRope {
    static constexpr bool PERM = false, AFTER_DRAIN = false;
    bf16_t* QK; bf16_t* VT; const float* rope;
    __device__ __forceinline__ void operator()(const f32x4 (&acc)[2][2][4][2], const pg8::Unit& u, int wr, int wc, int fr, int fq) const {
        asm volatile("" : "+v"(fr), "+v"(fq));
        const int rowt = u.pm * 256; const bool isctx = rowt >= TL;
        const int rl0 = rowt + wr * 64 + fr;
        if (u.pn < 5) {
            const int colb = u.pn * 256 + wc * 32 + 4 * fq;
#pragma unroll
            for (int ai = 0; ai < 2; ++ai)
#pragma unroll
                for (int m = 0; m < 4; ++m) { const int r = rl0 + ai * 128 + m * 16; const int t = r & 4095; const int pos = (wc & 1) ? (t & 63) : (t >> 6);
                    f32x4 cs0 = (f32x4){1.f, 0.f, 1.f, 0.f}, cs1 = cs0;
                    if (!isctx) { cs0 = *(const f32x4*)(rope + (pos * 16 + 4 * fq) * 2); cs1 = *(const f32x4*)(rope + (pos * 16 + 4 * fq + 2) * 2); }
#pragma unroll
                    for (int bj = 0; bj < 2; ++bj) { const f32x4 x1 = acc[ai][bj][m][0], x2 = acc[ai][bj][m][1];
                        f32x4 o1, o2;
                        o1[0] = x1[0] * cs0[0] - x2[0] * cs0[1]; o2[0] = x1[0] * cs0[1] + x2[0] * cs0[0];
                        o1[1] = x1[1] * cs0[2] - x2[1] * cs0[3]; o2[1] = x1[1] * cs0[3] + x2[1] * cs0[2];
                        o1[2] = x1[2] * cs1[0] - x2[2] * cs1[1]; o2[2] = x1[2] * cs1[1] + x2[2] * cs1[0];
                        o1[3] = x1[3] * cs1[2] - x2[3] * cs1[3]; o2[3] = x1[3] * cs1[3] + x2[3] * cs1[2];
                        bf16_t* p = QK + (size_t)r * 1280 + colb + bj * 128;
                        u32x2 w1, w2; w1.x = pk2(o1[0], o1[1]); w1.y = pk2(o1[2], o1[3]); w2.x = pk2(o2[0], o2[1]); w2.y = pk2(o2[2], o2[3]);
                        *(u32x2*)p = w1; *(u32x2*)(p + 16) = w2; } }
        } else {
            const int colb = wc * 32 + 4 * fq;
#pragma unroll
            for (int ai = 0; ai < 2; ++ai)
#pragma unroll
                for (int m = 0; m < 4; ++m) { const int r = rl0 + ai * 128 + m * 16; const int k32 = r & 31; const int rp = (r & ~31) + 8 * ((k32 >> 2) & 3) + 4 * (k32 >> 4) + (k32 & 3);
#pragma unroll
                    for (int bj = 0; bj < 2; ++bj)
#pragma unroll
                        for (int n = 0; n < 2; ++n)
#pragma unroll
                            for (int j = 0; j < 4; ++j) VT[(size_t)(colb + bj * 128 + n * 16 + j) * TA + rp] = (bf16_t)f2bf(acc[ai][bj][m][n][j]); }
        }
    }
};


#define XB_TMO      128
#define XB_XCNT(j)  (256  + 64 * (j))
#define XB_XSUB(j)  (1280 + 64 * (j))
#define XB_XGEN(j)  (2304 + 64 * (j))
#define XB_TOP      3328
#define XB_TOPGEN   3392
#define XCD_BAR_WORDS 3456
#define XB_SPIN_CAP (1u << 22)
__device__ __forceinline__ unsigned xb_ld(unsigned* p)              { return __hip_atomic_load(p, __ATOMIC_RELAXED, __HIP_MEMORY_SCOPE_AGENT); }
__device__ __forceinline__ unsigned xb_add(unsigned* p, unsigned v) { return __hip_atomic_fetch_add(p, v, __ATOMIC_RELAXED, __HIP_MEMORY_SCOPE_AGENT); }
__device__ __forceinline__ unsigned xb_xcc_id() { return (unsigned)__builtin_amdgcn_s_getreg((3 << 11) | 20) & 0xFu; }
#define XB_SPIN(cond, bar) do { unsigned _sp = 0; while (cond) { __builtin_amdgcn_s_sleep(1); \
    if ((++_sp & 255u) == 0u) { if (xb_ld(&(bar)[XB_TMO])) break; if (_sp > XB_SPIN_CAP) { atomicAdd(&(bar)[XB_TMO], 1u); break; } } } } while (0)
struct XcdBarrier { unsigned* bar; unsigned x; volatile LAS unsigned* st; };
__device__ __forceinline__ XcdBarrier xcd_barrier_post(unsigned* bar, volatile LAS unsigned* st) {
    XcdBarrier b; b.bar = bar; b.x = xb_xcc_id(); b.st = st;
    if (threadIdx.x == 0) (void)xb_add(&bar[XB_XCNT(b.x)], 1u);
    return b;
}
__device__ __forceinline__ void xcd_barrier_complete(unsigned* bar, unsigned x, unsigned& nloc, unsigned& nx) {
    const unsigned G = gridDim.x * gridDim.y * gridDim.z;
    unsigned sum, cnt, mine, sp = 0u;
    for (;;) {
        sum = 0u; cnt = 0u; mine = 0u;
#pragma unroll
        for (unsigned j = 0; j < 16; ++j) { const unsigned c = xb_ld(&bar[XB_XCNT(j)]); sum += c; cnt += (c > 0u) ? 1u : 0u; mine = (j == x) ? c : mine; }
        if (sum == G) break;
        __builtin_amdgcn_s_sleep(1);
        if ((++sp & 255u) == 0u) { if (xb_ld(&bar[XB_TMO])) break; if (sp > XB_SPIN_CAP) { atomicAdd(&bar[XB_TMO], 1u); break; } }
    }
    nloc = mine > 0u ? mine : 1u; nx = cnt > 0u ? cnt : 1u;
}
__device__ __forceinline__ void xcd_barrier(const XcdBarrier& b) {
    asm volatile("s_waitcnt vmcnt(0)" ::: "memory");
    __syncthreads();
    if (threadIdx.x == 0) {
        unsigned* bar = b.bar;
        __builtin_amdgcn_s_waitcnt(0);
        unsigned nloc = b.st[0], nx = b.st[1];
        if (nloc == 0u) { xcd_barrier_complete(bar, b.x, nloc, nx); b.st[0] = nloc; b.st[1] = nx; }
        const unsigned old = xb_add(&bar[XB_XSUB(b.x)], 1u);
        const unsigned gen = old / nloc;
        if (old + 1u == (gen + 1u) * nloc) {
            __builtin_amdgcn_fence(__ATOMIC_RELEASE, "agent");
            asm volatile("s_waitcnt vmcnt(0)" ::: "memory");
            const unsigned og = xb_add(&bar[XB_TOP], 1u);
            const unsigned tg = og / nx;
            if (og + 1u == (tg + 1u) * nx) xb_add(&bar[XB_TOPGEN], 1u);
            else XB_SPIN(xb_ld(&bar[XB_TOPGEN]) == tg, bar);
            __builtin_amdgcn_fence(__ATOMIC_ACQUIRE, "agent");
            xb_add(&bar[XB_XGEN(b.x)], 1u);
            asm volatile("s_waitcnt vmcnt(0)" ::: "memory");
        } else {
            XB_SPIN(xb_ld(&bar[XB_XGEN(b.x)]) == gen, bar);
            __builtin_amdgcn_fence(__ATOMIC_ACQUIRE, "agent");
            asm volatile("s_waitcnt vmcnt(0)" ::: "memory");
        }
    }
    __syncthreads();
}

struct Args { const float* in[37]; float* out; unsigned char* ws; };
enum { I_X = 0, I_C, I_CTX, I_CCTX, I_ADAW, I_ADAB, I_LN1G, I_LN1B, I_LN2G, I_LN2B, I_WUP, I_CONVW, I_CONVB, I_WDN, I_POOLW, I_POOLB, I_POOLS,
       I_WQKV, I_WOUT, I_SINK, I_LRE, I_LIM, I_LDT, I_BRE, I_BIM, I_CRE, I_CIM, I_SSMD, I_GLUA, I_GLUB, I_GWIN, I_GBIN, I_GLNG, I_GLNB, I_GWS, I_GBS, I_GWOUT };

struct Ctx { int tid, lane, wid, bid, nb, gw, ngw; LAS unsigned char* lds; };
typedef const __attribute__((address_space(4))) Args* KArgsPtr;
__device__ __forceinline__ KArgsPtr kargs() { KArgsPtr p = (KArgsPtr)__builtin_amdgcn_kernarg_segment_ptr(); asm volatile("" : "+s"(p)); return p; }
#define AIN(i) ((const float*)(kargs()->in[i]))

__device__ __forceinline__ void conv_weight(const Ctx& c, const float* W, int K, int N, bf16_t* WT, int mode) {
    LAS float* scr = (LAS float*)(c.lds + c.wid * 16384);
    const int nblk = N / 32, nitems = (K / 64) * nblk, lane = c.lane;
    for (int it = c.gw; it < nitems; it += c.ngw) {
        const int kb = it / nblk, nbk = it % nblk, k0 = 64 * kb, n0 = 32 * nbk;
        const int d0 = mode == 0 ? n0 : ((n0 >> 7) * 256 + (n0 & 127) + (mode == 2 ? 128 : 0));
#pragma unroll 8
        for (int i = 0; i < 32; ++i) { const int kk = 2 * i + (lane >> 5); scr[kk * 33 + (lane & 31)] = __builtin_nontemporal_load(W + (size_t)(k0 + kk) * N + n0 + (lane & 31)); }
        LDS_WAIT();
        const int cc = lane & 7;
#pragma unroll
        for (int j = 0; j < 4; ++j) { const int n = (lane >> 3) + 8 * j; const LAS float* s = scr + (8 * cc) * 33 + n;
            u32x4 o; o.x = pk2(s[0 * 33], s[1 * 33]); o.y = pk2(s[2 * 33], s[3 * 33]); o.z = pk2(s[4 * 33], s[5 * 33]); o.w = pk2(s[6 * 33], s[7 * 33]);
            *(u32x4*)(WT + (size_t)(d0 + n) * K + k0 + 8 * cc) = o; }
        LDS_WAIT();
    }
}
__device__ __forceinline__ void conv_plain(const Ctx& c, const float* W, bf16_t* O, int n) {
    for (int i = (c.bid * 512 + c.tid) * 4; i < n; i += c.nb * 512 * 4) { const f32x4 v = *(const f32x4*)(W + i); u32x2 w; w.x = pk2(v[0], v[1]); w.y = pk2(v[2], v[3]); *(u32x2*)(O + i) = w; }
}

__device__ __forceinline__ void cpow(float lre, float lim, float dt, int n, float& re, float& im) {
    const float mag = __expf(lre * dt * (float)n);
    double rev = (double)lim * (double)dt * (double)n * 0.15915494309189535;
    rev -= __builtin_rint(rev);
    const float r = (float)rev;
    re = mag * __builtin_amdgcn_cosf(r); im = mag * __builtin_amdgcn_sinf(r);
}
__device__ __forceinline__ void ssm_load_params(const Args& a, int d, int g, int tid, LAS float* lam, LAS float* dtp, LAS f32x2* bb, LAS f32x2* cc) {
    const int dg = d * 64 + g;
    const float dt = __expf(AIN(I_LDT)[dg]);
    if (tid < 64) { lam[2 * tid] = AIN(I_LRE)[dg * 64 + tid]; lam[2 * tid + 1] = AIN(I_LIM)[dg * 64 + tid]; }
    if (tid == 0) dtp[0] = dt;
    for (int i = tid; i < 1024; i += 512) {
        const int p = i >> 4;
        const float lre = AIN(I_LRE)[dg * 64 + p], lim = AIN(I_LIM)[dg * 64 + p];
        const float x = lre * dt, y = lim * dt;
        float cr, ci; { double rev = (double)lim * (double)dt * 0.15915494309189535; rev -= __builtin_rint(rev); const float r = (float)rev; cr = __builtin_amdgcn_cosf(r); ci = __builtin_amdgcn_sinf(r); }
        const float em1 = expm1f(x), ex = em1 + 1.0f;
        const float cm1 = (fabsf(y) < 0.25f) ? (-0.5f * y * y + (1.0f / 24.0f) * y * y * y * y - (1.0f / 720.0f) * y * y * y * y * y * y) : (cr - 1.0f);
        const float nr = em1 * cr + cm1, ni = ex * ci;
        const float den = 1.0f / (lre * lre + lim * lim);
        const float qr = (nr * lre + ni * lim) * den, qi = (ni * lre - nr * lim) * den;
        const float br = AIN(I_BRE)[(size_t)dg * 1024 + i], bi = AIN(I_BIM)[(size_t)dg * 1024 + i];
        bb[i] = (f32x2){qr * br - qi * bi, qr * bi + qi * br};
        cc[i] = (f32x2){AIN(I_CRE)[(size_t)dg * 1024 + i], AIN(I_CIM)[(size_t)dg * 1024 + i]};
    }
}

__device__ __forceinline__ void phase0(const Args& a, const Ctx& c) {
    unsigned char* ws = a.ws;
    {
        LAS float* sc = (LAS float*)c.lds;
        LAS float* red = (LAS float*)(c.lds + 20480);
        for (int i = c.tid; i < 5 * 1024; i += 512) { const int cnd = i >> 10, k = i & 1023; const float v = cnd < 4 ? AIN(I_C)[cnd * 1024 + k] : AIN(I_CCTX)[k]; sc[i] = siluf_(v); }
        __syncthreads();
        const int cl = c.tid & 15, kg = c.tid >> 4;
        for (int it = c.bid; it < 4 * 96; it += c.nb) {
            const int layer = it / 96, col0 = (it % 96) * 64;
            const float* W = AIN(I_ADAW) + (size_t)layer * 1024 * 6144 + col0 + 4 * cl;
            f32x4 acc[5];
#pragma unroll
            for (int q = 0; q < 5; ++q) acc[q] = (f32x4){0.f, 0.f, 0.f, 0.f};
#pragma unroll 8
            for (int kk = 0; kk < 32; ++kk) { const int k = kg * 32 + kk; const f32x4 w = __builtin_nontemporal_load((const f32x4*)(W + (size_t)k * 6144));
#pragma unroll
                for (int q = 0; q < 5; ++q) { const float s = sc[q * 1024 + k]; acc[q] += w * s; } }
#pragma unroll
            for (int q = 0; q < 5; ++q) *(LAS f32x4*)(red + (kg * 5 + q) * 64 + 4 * cl) = acc[q];
            __syncthreads();
            if (c.tid < 320) { const int q = c.tid >> 6, col = c.tid & 63; float s = AIN(I_ADAB)[layer * 6144 + col0 + col];
                for (int k2 = 0; k2 < 32; ++k2) s += red[(k2 * 5 + q) * 64 + col];
                ((float*)(ws + WS_MODS))[(layer * 5 + q) * 6144 + col0 + col] = s; }
            __syncthreads();
        }
    }
    for (int i = c.bid * 512 + c.tid; i < 2 * TL; i += c.nb * 512) ((float*)(ws + WS_VSTAT))[i] = 0.f;
    for (int i = c.bid * 512 + c.tid; i < 8 * TL * 2 + 8 * 64 * 64; i += c.nb * 512) ((unsigned*)(ws + WS_LNSTAT))[i] = 0u;
    for (int i = c.bid * 512 + c.tid; i < 64 * 16; i += c.nb * 512) { const int pos = i >> 4, k = i & 15; const float f = exp2f(-(float)k * (13.287712379549449f / 16.0f)); float s, co; __sincosf((float)pos * f, &s, &co);
        ((float*)(ws + WS_ROPE))[2 * i] = co; ((float*)(ws + WS_ROPE))[2 * i + 1] = s; }
    {
        LAS float* lam = (LAS float*)c.lds;
        LAS float* dtp = lam + 256;
        LAS f32x2* bb = (LAS f32x2*)(c.lds + 2048);
        LAS f32x2* cc = bb + 2048;
        LAS f32x2* Q = cc + 2048;
        for (int it = c.bid; it < 64 * 8; it += c.nb) {
            const int g = it >> 3, sl = it & 7;
            __syncthreads();
            ssm_load_params(a, 0, g, c.tid, lam, dtp, bb, cc);
            ssm_load_params(a, 1, g, c.tid, lam + 128, dtp + 1, bb + 1024, cc + 1024);
            __syncthreads();
            for (int li = sl * 16; li < sl * 16 + 16 && li < 127; ++li) {
                float out = 0.f;
                for (int d = 0; d < 2; ++d) {
                    int tau; if (d == 0) { if (li < 63) continue; tau = li - 63; } else { if (li > 63) continue; tau = 63 - li; }
                    __syncthreads();
                    for (int i = c.tid; i < 1024; i += 512) { const int p = i & 63; float pr, pi; cpow(lam[d * 128 + 2 * p], lam[d * 128 + 2 * p + 1], dtp[d], tau, pr, pi);
                        const f32x2 cv = cc[d * 1024 + i]; Q[i] = (f32x2){cv.x * pr - cv.y * pi, cv.x * pi + cv.y * pr}; }
                    __syncthreads();
                    if (c.tid < 256) { const int cq = c.tid >> 4, cp = c.tid & 15;
                        for (int p = 0; p < 64; ++p) { const f32x2 q = Q[cq * 64 + p], b = bb[d * 1024 + p * 16 + cp]; out += q.x * b.x - q.y * b.y; } }
                }
                if (c.tid < 256) ((bf16_t*)(ws + WS_KK))[((size_t)(g * 127 + li)) * 256 + c.tid] = (bf16_t)f2bf(out);
            }
        }
        __syncthreads();
    }
    conv_weight(c, AIN(I_WUP), 1024, F2, (bf16_t*)(ws + WS_WUP), 0);
    conv_weight(c, AIN(I_WDN), FH, 1024, (bf16_t*)(ws + WS_WDN), 0);
    for (int g = 0; g < 4; ++g) conv_weight(c, AIN(I_POOLW) + g * 65536, 256, 256, (bf16_t*)(ws + WS_WPOOL) + g * 65536, 0);
    conv_weight(c, AIN(I_WQKV), 1024, 1536, (bf16_t*)(ws + WS_WQKV), 0);
    conv_weight(c, AIN(I_WOUT), 1024, 1024, (bf16_t*)(ws + WS_WO), 0);
    conv_weight(c, AIN(I_GLUA), 1024, 1024, (bf16_t*)(ws + WS_WGLU), 1);
    conv_weight(c, AIN(I_GLUB), 1024, 1024, (bf16_t*)(ws + WS_WGLU), 2);
    conv_weight(c, AIN(I_GWIN), 1024, 4096, (bf16_t*)(ws + WS_WGIN), 0);
    conv_weight(c, AIN(I_GWOUT), 2048, 1024, (bf16_t*)(ws + WS_WGOUT), 0);
    conv_plain(c, AIN(I_GWS), (bf16_t*)(ws + WS_WS16), 8 * 128 * 128);
}

__device__ __forceinline__ void ssm_tables(const Args& a, const Ctx& c) {
    unsigned char* ws = a.ws;
    LAS float* lam = (LAS float*)c.lds; LAS float* dtp = lam + 128;
    LAS f32x2* bb = (LAS f32x2*)(c.lds + 2048); LAS f32x2* cc = bb + 1024; LAS f32x2* P = cc + 1024;
    for (int it = c.bid; it < 128; it += c.nb) {
        const int d = it >> 6, g = it & 63;
        __syncthreads();
        ssm_load_params(a, d, g, c.tid, lam, dtp, bb, cc);
        __syncthreads();
        for (int i = c.tid; i < 65 * 64; i += 512) { const int n = i >> 6, p = i & 63; float pr, pi; cpow(lam[2 * p], lam[2 * p + 1], dtp[0], n, pr, pi); P[i] = (f32x2){pr, pi}; }
        __syncthreads();
        if (c.tid < 64) ((f32x2*)(ws + WS_LAML))[(d * 64 + g) * 64 + c.tid] = P[64 * 64 + c.tid];
        bf16_t* ET = (bf16_t*)(ws + WS_ET) + (size_t)(d * 64 + g) * 128 * 1024;
        for (int i = c.tid; i < 64 * 128; i += 512) {
            const int p = i >> 7, kg8 = i & 127, tp = kg8 >> 1, c0 = (kg8 & 1) * 8;
            const f32x2 pw = P[(d ? tp : 63 - tp) * 64 + p];
            float re[8], im[8];
#pragma unroll
            for (int j = 0; j < 8; ++j) { const f32x2 b = bb[p * 16 + c0 + j]; re[j] = pw.x * b.x - pw.y * b.y; im[j] = pw.x * b.y + pw.y * b.x; }
            u32x4 wr_, wi_; wr_.x = pk2(re[0], re[1]); wr_.y = pk2(re[2], re[3]); wr_.z = pk2(re[4], re[5]); wr_.w = pk2(re[6], re[7]);
            wi_.x = pk2(im[0], im[1]); wi_.y = pk2(im[2], im[3]); wi_.z = pk2(im[4], im[5]); wi_.w = pk2(im[6], im[7]);
            *(u32x4*)(ET + (size_t)(2 * p) * 1024 + kg8 * 8) = wr_; *(u32x4*)(ET + (size_t)(2 * p + 1) * 1024 + kg8 * 8) = wi_;
        }
        bf16_t* GT = (bf16_t*)(ws + WS_GT) + (size_t)(d * 64 + g) * 1024 * 128;
        for (int i = c.tid; i < 1024 * 16; i += 512) {
            const int n = i >> 4, p0 = (i & 15) * 4, t = n >> 4, cq = n & 15;
            float v[8];
#pragma unroll
            for (int j = 0; j < 4; ++j) { const f32x2 pw = P[(d ? 64 - t : t + 1) * 64 + p0 + j], cv = cc[cq * 64 + p0 + j]; v[2 * j] = cv.x * pw.x - cv.y * pw.y; v[2 * j + 1] = -(cv.x * pw.y + cv.y * pw.x); }
            u32x4 w; w.x = pk2(v[0], v[1]); w.y = pk2(v[2], v[3]); w.z = pk2(v[4], v[5]); w.w = pk2(v[6], v[7]);
            *(u32x4*)(GT + (size_t)n * 128 + 2 * p0) = w;
        }
    }
    __syncthreads();
}

__device__ __forceinline__ void ln_pass(const Ctx& c, int row_begin, int M, float* res_lat, float* res_ctx, const float* g, const float* b, bf16_t* H, const float* mods, int sh_off, int sc_off, const float* parts, int nks, const float* mods_gate, int gate_off, int hgm = 0) {
    float* const dry = nullptr;
    for (int row0 = row_begin + 2 * c.gw; row0 < M; row0 += 2 * c.ngw) {
        f32x4* xr[2]; f32x4 v[2][4]; float s[2];
#pragma unroll
        for (int r = 0; r < 2; ++r) { const int row = row0 + r; float* p = row < TL ? res_lat + (size_t)row * D : res_ctx + (size_t)(row - TL) * D; xr[r] = (f32x4*)p + c.lane;
#pragma unroll
            for (int j = 0; j < 4; ++j) v[r][j] = xr[r][64 * j];
        }
        if (parts != nullptr && row0 >= TL) {
            f32x4 ps[2][4];
#pragma unroll
            for (int r = 0; r < 2; ++r)
#pragma unroll
                for (int j = 0; j < 4; ++j) ps[r][j] = (f32x4){0.f, 0.f, 0.f, 0.f};
#pragma unroll 1
            for (int ks = 0; ks < nks; ++ks) {
                const f32x4* pr = (const f32x4*)(parts + (size_t)ks * 1024 * 1024 + (size_t)(row0 - TL) * D) + c.lane;
#pragma unroll
                for (int r = 0; r < 2; ++r)
#pragma unroll
                    for (int j = 0; j < 4; ++j) ps[r][j] += pr[r * 256 + 64 * j];
            }
#pragma unroll
            for (int j = 0; j < 4; ++j) { const f32x4 g4 = *(const f32x4*)(mods_gate + 4 * 6144 + gate_off + 4 * c.lane + 256 * j);
#pragma unroll
                for (int r = 0; r < 2; ++r) v[r][j] = ALPHA * v[r][j] + g4 * ps[r][j]; }
        }
#pragma unroll
        for (int r = 0; r < 2; ++r) { s[r] = 0.f;
#pragma unroll
            for (int j = 0; j < 4; ++j) s[r] += (v[r][j][0] + v[r][j][1]) + (v[r][j][2] + v[r][j][3]); }
        float mean[2], rstd[2];
#pragma unroll
        for (int r = 0; r < 2; ++r) mean[r] = wave_sum(s[r]) * (1.f / D);
#pragma unroll
        for (int r = 0; r < 2; ++r) { float s2 = 0.f;
#pragma unroll
            for (int j = 0; j < 4; ++j) { v[r][j] = v[r][j] - mean[r]; s2 += (v[r][j][0] * v[r][j][0] + v[r][j][1] * v[r][j][1]) + (v[r][j][2] * v[r][j][2] + v[r][j][3] * v[r][j][3]); }
            s[r] = s2; }
#pragma unroll
        for (int r = 0; r < 2; ++r) rstd[r] = __builtin_amdgcn_rsqf(wave_sum(s[r]) * (1.f / D) + LN_EPS);
        const int cond = row0 < TL ? (row0 >> 12) : 4;
#pragma unroll
        for (int j = 0; j < 4; ++j) { const int col = 4 * c.lane + 256 * j; const f32x4 g4 = *(const f32x4*)(g + col), b4 = *(const f32x4*)(b + col);
            f32x4 sh = (f32x4){0.f, 0.f, 0.f, 0.f}, sc = sh;
            if (H) { sh = *(const f32x4*)(mods + cond * 6144 + sh_off + col); sc = 1.0f + *(const f32x4*)(mods + cond * 6144 + sc_off + col); }
#pragma unroll
            for (int r = 0; r < 2; ++r) { const int row = row0 + r;
                const f32x4 x = v[r][j] * rstd[r] * g4 + b4;
                if (dry) ((f32x4*)(dry + (size_t)row * D))[c.lane + 64 * j] = x; else xr[r][64 * j] = x;
                if (H) { const f32x4 h = x * sc + sh; u32x2 w; w.x = pk2(h[0], h[1]); w.y = pk2(h[2], h[3]);
                    if (hgm) *(u32x2*)(H + ((size_t)(col >> 4) * TA + row) * 16 + (col & 15)) = w; else *(u32x2*)(H + (size_t)row * D + col) = w; } } }
    }
}

template <int W> __device__ __forceinline__ void pool_rows(const float* __restrict__ src, int t0, int n, f32x4 sc1, bf16_t* __restrict__ dst) {
    f32x4 R[8 + W - 1];
#pragma unroll
    for (int q = 0; q < 8 + W - 1; ++q) { const int t = t0 - W / 2 + q; R[q] = (t >= 0 && t < n) ? *(const f32x4*)(src + (size_t)t * D) : (f32x4){0.f, 0.f, 0.f, 0.f}; }
#pragma unroll
    for (int i = 0; i < 8; ++i) {
        f32x4 s = R[i];
#pragma unroll
        for (int k = 1; k < W; ++k) s += R[i + k];
        const int t = t0 + i, lo = max(t - W / 2, 0), hi = min(t - W / 2 + W, n);
        const f32x4 mx = (s * __builtin_amdgcn_rcpf((float)(hi - lo)) - R[i + W / 2]) * sc1;
        u32x2 o; o.x = pk2(mx[0], mx[1]); o.y = pk2(mx[2], mx[3]);
        *(u32x2*)(dst + (size_t)i * D) = o;
    }
}
__device__ __forceinline__ void pool_mix(const Args& a, const Ctx& c, const float* mods0, bf16_t* MIX) {
    for (int item = c.bid * 512 + c.tid; item < (TA / 8) * 256; item += c.nb * 512) {
        const int row0 = (item >> 8) * 8, col = (item & 255) * 4, grp = col >> 8;
        const float* src; int t0, n, cond;
        if (row0 < TL) { t0 = row0 & 4095; n = SEQ; src = AIN(I_X) + (size_t)(row0 - t0) * D + col; cond = row0 >> 12; }
        else { const int rr = row0 - TL; t0 = rr & 255; n = CTXL; src = AIN(I_CTX) + (size_t)(rr - t0) * D + col; cond = 4; }
        const f32x4 sc1 = 1.0f + *(const f32x4*)(mods0 + cond * 6144 + MOD_SC1 + col);
        bf16_t* dst = MIX + (size_t)row0 * D + col;
        if (grp == 0) pool_rows<2>(src, t0, n, sc1, dst);
        else if (grp == 1) pool_rows<4>(src, t0, n, sc1, dst);
        else if (grp == 2) pool_rows<8>(src, t0, n, sc1, dst);
        else pool_rows<16>(src, t0, n, sc1, dst);
    }
}

struct CgRow { u32x4 v, g; };
__device__ __forceinline__ CgRow cg_load(const bf16_t* p, bool ok) { CgRow r; const u32x4 z = (u32x4){0u, 0u, 0u, 0u}; r.v = ok ? __builtin_nontemporal_load((const u32x4*)p) : z; r.g = ok ? __builtin_nontemporal_load((const u32x4*)(p + FH)) : z; return r; }
__device__ __forceinline__ void conv_gate(const Ctx& c, int M, const bf16_t* __restrict__ A, bf16_t* __restrict__ HID, const float* __restrict__ cw, const float* __restrict__ cb) {
    const int nitems = (M >> 4) * 352;
    for (int item = c.bid * 512 + c.tid; item < nitems; item += c.nb * 512) {
        const int chunk = item / 352, j = (item - chunk * 352) * 8, row0 = chunk * 16;
        int t0, n; if (row0 < TL) { t0 = row0 & 4095; n = SEQ; } else { t0 = (row0 - TL) & 255; n = CTXL; }
        f32x4 wv[3][2], wg[3][2], bv[2], bg[2];
#pragma unroll
        for (int tap = 0; tap < 3; ++tap)
#pragma unroll
            for (int h = 0; h < 2; ++h) { wv[tap][h] = *(const f32x4*)(cw + tap * F2 + j + 4 * h); wg[tap][h] = *(const f32x4*)(cw + tap * F2 + FH + j + 4 * h); }
#pragma unroll
        for (int h = 0; h < 2; ++h) { bv[h] = *(const f32x4*)(cb + j + 4 * h); bg[h] = *(const f32x4*)(cb + FH + j + 4 * h); }
        const bf16_t* ap = A + (size_t)row0 * F2 + j;
        CgRow R[5];
        R[0] = cg_load(ap - F2, t0 > 0);
#pragma unroll
        for (int q = 1; q < 5; ++q) R[q] = cg_load(ap + (size_t)(q - 1) * F2, true);
#pragma unroll
        for (int i = 0; i < 16; ++i) {
            const CgRow& P = R[i % 5]; const CgRow& C = R[(i + 1) % 5]; const CgRow& Nx = R[(i + 2) % 5];
            unsigned o[4];
#pragma unroll
            for (int q = 0; q < 4; ++q) {
                const int h = q >> 1, e = (q & 1) * 2;
                const float v0 = bv[h][e] + bflo(P.v[q]) * wv[0][h][e] + bflo(C.v[q]) * wv[1][h][e] + bflo(Nx.v[q]) * wv[2][h][e];
                const float v1 = bv[h][e + 1] + bfhi(P.v[q]) * wv[0][h][e + 1] + bfhi(C.v[q]) * wv[1][h][e + 1] + bfhi(Nx.v[q]) * wv[2][h][e + 1];
                const float g0 = bg[h][e] + bflo(P.g[q]) * wg[0][h][e] + bflo(C.g[q]) * wg[1][h][e] + bflo(Nx.g[q]) * wg[2][h][e];
                const float g1 = bg[h][e + 1] + bfhi(P.g[q]) * wg[0][h][e + 1] + bfhi(C.g[q]) * wg[1][h][e + 1] + bfhi(Nx.g[q]) * wg[2][h][e + 1];
                o[q] = pk2(v0 * siluf_(g0), v1 * siluf_(g1));
            }
            *(u32x4*)(HID + (size_t)(row0 + i) * FH + j) = (u32x4){o[0], o[1], o[2], o[3]};
            if (i + 4 <= 16) { const bool ok = (i + 4 < 16) || (t0 + 16 < n); R[i % 5] = cg_load(ap + (size_t)(i + 4) * F2, ok); }
        }
    }
}

constexpr int ANQ = 4;
__device__ __forceinline__ void att_load(bf16x8 (&KF)[2][2], bf16x8 (&VF)[4], const bf16_t* __restrict__ QK, const bf16_t* __restrict__ VT, int kr, int hk, int l15, int q4) {
#pragma unroll
    for (int kb = 0; kb < 2; ++kb)
#pragma unroll
        for (int ks = 0; ks < 2; ++ks) KF[kb][ks] = *(const bf16x8*)(QK + (size_t)(kr + 16 * kb + l15) * 1280 + 1024 + 64 * hk + 32 * ks + 8 * q4);
#pragma unroll
    for (int db = 0; db < 4; ++db) VF[db] = *(const bf16x8*)(VT + (size_t)(64 * hk + 16 * db + l15) * TA + kr + 8 * q4);
}
__device__ __forceinline__ void att_tile(const bf16x8 (&KF)[2][2], const bf16x8 (&VF)[4], const bf16x8 (&QF)[ANQ][2], f32x4 (&Oa)[ANQ][4], float (&mrun)[ANQ], float (&lrun)[ANQ],
                                         bool need_mask, int kpos0, int qoff, int l15, int q4) {
    const float C2 = 0.18033688011112042f;
#pragma unroll
    for (int qb = 0; qb < ANQ; ++qb) {
        f32x4 s[2];
        __builtin_amdgcn_s_setprio(1);
#pragma unroll
        for (int kb = 0; kb < 2; ++kb) { s[kb] = mfma16(KF[kb][0], QF[qb][0], (f32x4){0.f, 0.f, 0.f, 0.f}); s[kb] = mfma16(KF[kb][1], QF[qb][1], s[kb]); }
        __builtin_amdgcn_s_setprio(0);
        if (need_mask) { const int qpos = qoff + 16 * qb + l15;
#pragma unroll
            for (int kb = 0; kb < 2; ++kb)
#pragma unroll
                for (int j = 0; j < 4; ++j) { const int dlt = kpos0 + 16 * kb + 4 * q4 + j - qpos; if (dlt > 128 || dlt < -128) s[kb][j] = -1e30f; } }
        float mx = fmaxf(fmaxf(fmaxf(s[0][0], s[0][1]), fmaxf(s[0][2], s[0][3])), fmaxf(fmaxf(s[1][0], s[1][1]), fmaxf(s[1][2], s[1][3])));
        mx = fmaxf(mx, __shfl_xor(mx, 16)); mx = fmaxf(mx, __shfl_xor(mx, 32));
        if (__builtin_amdgcn_ballot_w64(mx > mrun[qb]) != 0ull) {
            const float mnew = fmaxf(mrun[qb], mx), corr = __builtin_amdgcn_exp2f((mrun[qb] - mnew) * C2);
            mrun[qb] = mnew; lrun[qb] *= corr;
#pragma unroll
            for (int db = 0; db < 4; ++db) Oa[qb][db] = Oa[qb][db] * corr;
        }
        const float nm = -mrun[qb] * C2;
        float p[8];
#pragma unroll
        for (int kb = 0; kb < 2; ++kb)
#pragma unroll
            for (int j = 0; j < 4; ++j) p[kb * 4 + j] = __builtin_amdgcn_exp2f(fmaf(s[kb][j], C2, nm));
        lrun[qb] += ((p[0] + p[1]) + (p[2] + p[3])) + ((p[4] + p[5]) + (p[6] + p[7]));
        u32x4 pw; pw.x = pk2(p[0], p[1]); pw.y = pk2(p[2], p[3]); pw.z = pk2(p[4], p[5]); pw.w = pk2(p[6], p[7]);
        const bf16x8 PF = __builtin_bit_cast(bf16x8, pw);
        __builtin_amdgcn_s_setprio(1);
#pragma unroll
        for (int db = 0; db < 4; ++db) Oa[qb][db] = mfma16(VF[db], PF, Oa[qb][db]);
        __builtin_amdgcn_s_setprio(0);
    }
}
__device__ __forceinline__ void attn_phase(const Args& a, const Ctx& c, const bf16_t* QK, const bf16_t* VT, bf16_t* O) {
    const int lane = c.lane, w = c.wid, l15 = lane & 15, q4 = lane >> 4;
    const float* sink = AIN(I_SINK);
    for (int it = c.bid; it < 512 + 32; it += c.nb) {
        int b, nbq, hk; const bool isctx = it >= 512;
        if (!isctx) { hk = it & 3; nbq = (it >> 2) & 31; b = it >> 7; }
        else { const int i2 = it - 512; hk = i2 & 3; nbq = (i2 >> 2) & 1; b = i2 >> 3; }
        const int hq = hk * 4 + (w >> 1);
        const int qoff = nbq * 128 + 64 * (w & 1);
        const int r0 = (isctx ? TL + b * CTXL : b * SEQ) + qoff;
        bf16x8 QF[ANQ][2];
#pragma unroll
        for (int qb = 0; qb < ANQ; ++qb)
#pragma unroll
            for (int ks = 0; ks < 2; ++ks) QF[qb][ks] = *(const bf16x8*)(QK + (size_t)(r0 + 16 * qb + l15) * 1280 + 64 * hq + 32 * ks + 8 * q4);
        f32x4 Oa[ANQ][4]; float mrun[ANQ], lrun[ANQ];
        const float sk = sink[hq] * 8.0f;
#pragma unroll
        for (int qb = 0; qb < ANQ; ++qb) { mrun[qb] = sk; lrun[qb] = (q4 == 0) ? 1.0f : 0.0f;
#pragma unroll
            for (int db = 0; db < 4; ++db) Oa[qb][db] = (f32x4){0.f, 0.f, 0.f, 0.f}; }
        int kp0 = 0, kp1 = 0;
        if (!isctx) { kp0 = max(0, 128 * (nbq - 1)); kp1 = min(SEQ, 128 * (nbq + 2)); kp0 = max(kp0, (qoff - 128) & ~31); kp1 = min(kp1, ((qoff + 63 + 128) & ~31) + 32); }
        const int nband = (kp1 - kp0) >> 5, nt = nband + 8;
        const int krb = b * SEQ + kp0, krc = TL + b * CTXL;
#define ATT_KR(TT) ((TT) < nband ? krb + 32 * (TT) : krc + 32 * ((TT) - nband))
#define ATT_MASK(TT) ((TT) < nband && ((kp0 + 32 * (TT) + 31 - qoff > 128) || (kp0 + 32 * (TT) - (qoff + 63) < -128)))
        bf16x8 KA[2][2], VA[4], KB[2][2], VB[4];
        att_load(KA, VA, QK, VT, ATT_KR(0), hk, l15, q4);
        for (int tt = 0; tt < nt; tt += 2) {
            if (tt + 1 < nt) att_load(KB, VB, QK, VT, ATT_KR(tt + 1), hk, l15, q4);
            att_tile(KA, VA, QF, Oa, mrun, lrun, ATT_MASK(tt), kp0 + 32 * tt, qoff, l15, q4);
            if (tt + 1 < nt) {
                if (tt + 2 < nt) att_load(KA, VA, QK, VT, ATT_KR(tt + 2), hk, l15, q4);
                att_tile(KB, VB, QF, Oa, mrun, lrun, ATT_MASK(tt + 1), kp0 + 32 * (tt + 1), qoff, l15, q4);
            }
        }
#undef ATT_KR
#undef ATT_MASK
#pragma unroll
        for (int qb = 0; qb < ANQ; ++qb) {
            float l = lrun[qb]; l += __shfl_xor(l, 16); l += __shfl_xor(l, 32);
            const float inv = __builtin_amdgcn_rcpf(l);
            bf16_t* op = O + (size_t)(r0 + 16 * qb + l15) * D + 64 * hq + 4 * q4;
#pragma unroll
            for (int db = 0; db < 4; ++db) { const f32x4 o = Oa[qb][db] * inv; u32x2 wv; wv.x = pk2(o[0], o[1]); wv.y = pk2(o[2], o[3]); *(u32x2*)(op + 16 * db) = wv; }
        }
    }
}

__device__ __forceinline__ int ssm_chunk_row(int d, int b, int k) {
    if (d == 0) return k < 4 ? TL + b * CTXL + 64 * k : b * SEQ + 64 * (k - 4);
    return k < 4 ? TL + b * CTXL + 64 * (3 - k) : b * SEQ + 64 * (67 - k);
}
__device__ __forceinline__ void ssm_s1(const Ctx& c, const bf16_t* __restrict__ H, const bf16_t* __restrict__ ET, float* __restrict__ SLOC) {
    const int l15 = c.lane & 15, q4 = c.lane >> 4, w = c.wid;
    LAS unsigned char* ETs = c.lds;
    LAS unsigned char* Us = c.lds + 17408;
    for (int it = c.bid; it < 256; it += c.nb) {
        const int dg = it >> 1, nh = it & 1, d = dg >> 6, g = dg & 63;
        const int nbk = w >> 1, mp = w & 1;
        f32x4 acc[9];
#pragma unroll
        for (int i = 0; i < 9; ++i) acc[i] = (f32x4){0.f, 0.f, 0.f, 0.f};
        u32x4 pe[2], pu[9];
#define S1_FETCH(KC) do { _Pragma("unroll") for (int q = 0; q < 2; ++q) { const int i = c.tid + 512 * q; const int n = i >> 4, pc = i & 15; \
                pe[q] = *(const u32x4*)(ET + ((size_t)dg * 128 + 64 * nh + n) * 1024 + 128 * (KC) + 8 * pc); } \
            _Pragma("unroll") for (int q = 0; q < 9; ++q) { const int i = c.tid + 512 * q; if (i < 272 * 16) { const int m = i >> 4, pc = i & 15, b = m / 68, k = m - b * 68; \
                pu[q] = *(const u32x4*)(H + ((size_t)g * TA + ssm_chunk_row(d, b, k) + 8 * (KC) + (pc >> 1)) * 16 + 8 * (pc & 1)); } } } while (0)
        S1_FETCH(0);
        for (int kc = 0; kc < 8; ++kc) {
            __syncthreads();
#pragma unroll
            for (int q = 0; q < 2; ++q) { const int i = c.tid + 512 * q; *(LAS u32x4*)(ETs + (i >> 4) * 272 + (i & 15) * 16) = pe[q]; }
#pragma unroll
            for (int q = 0; q < 9; ++q) { const int i = c.tid + 512 * q; if (i < 272 * 16) *(LAS u32x4*)(Us + (i >> 4) * 272 + (i & 15) * 16) = pu[q]; }
            __syncthreads();
            if (kc + 1 < 8) S1_FETCH(kc + 1);
#pragma unroll
            for (int ks = 0; ks < 4; ++ks) {
                const bf16x8 ef = *(const LAS bf16x8*)(ETs + (16 * nbk + l15) * 272 + 64 * ks + 16 * q4);
#pragma unroll
                for (int i = 0; i < 9; ++i) { const int mb = 2 * i + mp; if (mb < 17) { const bf16x8 uf = *(const LAS bf16x8*)(Us + (16 * mb + l15) * 272 + 64 * ks + 16 * q4); acc[i] = mfma16(ef, uf, acc[i]); } }
            }
        }
#undef S1_FETCH
#pragma unroll
        for (int i = 0; i < 9; ++i) { const int mb = 2 * i + mp; if (mb < 17) *(f32x4*)(SLOC + ((size_t)dg * 272 + 16 * mb + l15) * 128 + 64 * nh + 16 * nbk + 4 * q4) = acc[i]; }
    }
    __syncthreads();
}
__device__ __forceinline__ void ssm_s2(const Ctx& c, const float* SLOC, const f32x2* LAML, bf16_t* SIN) {
    const int gt = c.bid * 512 + c.tid;
    if (gt < 2 * 64 * 4 * 64) {
        const int p = gt & 63, b = (gt >> 6) & 3, dg = gt >> 8;
        const f32x2 lm = LAML[dg * 64 + p];
        float sr = 0.f, si = 0.f;
        const f32x2* sl = (const f32x2*)(SLOC + ((size_t)dg * 272 + b * 68) * 128) + p;
        unsigned* so = (unsigned*)(SIN + ((size_t)dg * 272 + b * 68) * 128) + p;
#pragma unroll 4
        for (int k = 0; k < 68; ++k) {
            so[(size_t)k * 64] = pk2(sr, si);
            const f32x2 v = sl[(size_t)k * 64];
            const float nr = lm.x * sr - lm.y * si + v.x, ni = lm.x * si + lm.y * sr + v.y;
            sr = nr; si = ni;
        }
    }
}
__device__ __forceinline__ void ssm_s3(const Args& a, const Ctx& c, const bf16_t* H, const bf16_t* KK, const bf16_t* GT, const float* SLOC, const f32x2* LAML, bf16_t* GACT) {
    const int l15 = c.lane & 15, q4 = c.lane >> 4, w = c.wid;
    LAS unsigned char* U = c.lds;
    const float* dsk = AIN(I_SSMD);
    LAS unsigned char* SINL = c.lds + 139264;
    for (int it = c.bid; it < 64 * 8; it += c.nb) {
        const int g = it >> 3, mg = it & 7, b = mg >> 1, j0 = 32 * (mg & 1);
        __syncthreads();
        for (int i = c.tid; i < 2 * 68 * 32; i += 512) { const int d = i / (68 * 32), r = i - d * (68 * 32);
            *(LAS f32x4*)(U + (size_t)i * 16) = *(const f32x4*)(SLOC + ((size_t)(d * 64 + g) * 272 + b * 68) * 128 + (size_t)r * 4); }
        __syncthreads();
        if (c.tid < 128) { const int d = c.tid >> 6, p = c.tid & 63; const f32x2 lm = LAML[(d * 64 + g) * 64 + p];
            float sr = 0.f, si = 0.f;
            for (int k = 0; k < 68; ++k) {
                const int jj = d ? (67 - k - j0) : (k - 4 - j0);
                if (jj >= 0 && jj < 32) *(LAS unsigned*)(SINL + ((d * 32 + jj) * 128 + 2 * p) * 2) = pk2(sr, si);
                const f32x2 v = *(const LAS f32x2*)(U + ((size_t)(d * 68 + k) * 128 + 2 * p) * 4);
                const float nr = lm.x * sr - lm.y * si + v.x, ni = lm.x * si + lm.y * sr + v.y; sr = nr; si = ni; } }
        __syncthreads();
        for (int i = c.tid; i < 32 * 64 * 2; i += 512) { const int ml = i >> 7, tp = (i >> 1) & 63, hf = i & 1;
            const u32x4 v = *(const u32x4*)(H + ((size_t)g * TA + b * SEQ + 64 * (j0 + ml) + tp) * 16 + 8 * hf);
            *(LAS u32x4*)(U + ml * 2064 + (tp * 16 + 8 * hf) * 2) = v; }
        for (int i = c.tid; i < 4064; i += 512) *(LAS u32x4*)(U + 66048 + i * 16) = *(const u32x4*)(KK + (size_t)g * 127 * 256 + i * 8);
        __syncthreads();
#pragma unroll 1
        for (int par = 0; par < 2; ++par) {
            f32x4 acc[4][2];
#pragma unroll
            for (int i = 0; i < 4; ++i) { acc[i][0] = (f32x4){0.f, 0.f, 0.f, 0.f}; acc[i][1] = acc[i][0]; }
            bf16x8 ua[4], ub[4];
            const int col = 16 * g + 4 * q4; const f32x4 dv = *(const f32x4*)(dsk + col);
            u32x2 hv[4][2];
#pragma unroll
            for (int i = 0; i < 4; ++i)
#pragma unroll
                for (int mb = 0; mb < 2; ++mb) hv[i][mb] = *(const u32x2*)(H + ((size_t)g * TA + (size_t)b * SEQ + 64 * (j0 + 16 * mb + l15) + 8 * w + par + 2 * i) * 16 + 4 * q4);
            LAS unsigned char* u0 = U + l15 * 2064 + 16 * q4;
            LAS unsigned char* kbase = U + 66048 + (8 * w + par + 63 - (q4 >> 1)) * 512 + l15 * 32 + 16 * (q4 & 1);
#pragma unroll 1
            for (int e4 = 0; e4 < 36; e4 += 4) {
#pragma unroll
                for (int sft = 0; sft < 4; ++sft) {
                    const int ksn = e4 + sft, e = ksn - 3;
                    if (ksn < 32) { ua[sft] = *(const LAS bf16x8*)(u0 + 64 * ksn); ub[sft] = *(const LAS bf16x8*)(u0 + 16 * 2064 + 64 * ksn); }
                    if (e <= 31) {
                        const bf16x8 kf = *(const LAS bf16x8*)(kbase - e * 1024);
#pragma unroll
                        for (int i = 0; i < 4; ++i) { const int ks = e + i;
                            if (ks >= 0 && ks <= 31) { acc[i][0] = mfma16(kf, ua[(sft + i + 1) & 3], acc[i][0]); acc[i][1] = mfma16(kf, ub[(sft + i + 1) & 3], acc[i][1]); } }
                    }
                }
            }
            asm volatile("" ::: "memory");
            bf16x8 gA[4], gB[4];
#define S3_GT_LOAD(dst, stp) do { _Pragma("unroll") for (int i = 0; i < 4; ++i) \
                dst[i] = *(const bf16x8*)(GT + ((size_t)(((stp) >> 2) * 64 + g) * 1024 + 16 * (8 * w + par + 2 * i) + l15) * 128 + 32 * ((stp) & 3) + 8 * q4); } while (0)
#define S3_STEP(cur, stp) do { const bf16x8 s0_ = *(const LAS bf16x8*)(SINL + ((((stp) >> 2) * 32 + l15) * 128 + 32 * ((stp) & 3) + 8 * q4) * 2), s1_ = *(const LAS bf16x8*)(SINL + ((((stp) >> 2) * 32 + 16 + l15) * 128 + 32 * ((stp) & 3) + 8 * q4) * 2); \
                _Pragma("unroll") for (int i = 0; i < 4; ++i) { acc[i][0] = mfma16(cur[i], s0_, acc[i][0]); acc[i][1] = mfma16(cur[i], s1_, acc[i][1]); } } while (0)
            S3_GT_LOAD(gA, 0);
            S3_GT_LOAD(gB, 1); S3_STEP(gA, 0);
            S3_GT_LOAD(gA, 2); S3_STEP(gB, 1);
            S3_GT_LOAD(gB, 3); S3_STEP(gA, 2);
            S3_GT_LOAD(gA, 4); S3_STEP(gB, 3);
            S3_GT_LOAD(gB, 5); S3_STEP(gA, 4);
            S3_GT_LOAD(gA, 6); S3_STEP(gB, 5);
            S3_GT_LOAD(gB, 7); S3_STEP(gA, 6);
            S3_STEP(gB, 7);
#undef S3_STEP
#undef S3_GT_LOAD
#pragma unroll
            for (int i = 0; i < 4; ++i) { const int t = 8 * w + par + 2 * i;
#pragma unroll
                for (int mb = 0; mb < 2; ++mb) { const size_t row = (size_t)b * SEQ + 64 * (j0 + 16 * mb + l15) + t; const f32x4 y = acc[i][mb]; const u32x2 hq_ = hv[i][mb];
                    const float o0 = gelu_tanh(y[0] + dv[0] * bflo(hq_.x)), o1 = gelu_tanh(y[1] + dv[1] * bfhi(hq_.x)), o2 = gelu_tanh(y[2] + dv[2] * bflo(hq_.y)), o3 = gelu_tanh(y[3] + dv[3] * bfhi(hq_.y));
                    u32x2 ov; ov.x = pk2(o0, o1); ov.y = pk2(o2, o3); *(u32x2*)(GACT + row * D + col) = ov; } }
        }
    }
    __syncthreads();
}

__device__ __forceinline__ void gmlp_stats(const Ctx& c, const bf16_t* Z, float* VSTAT) {
    for (int row = c.gw; row < TL; row += c.ngw) {
        const u32x4* zr = (const u32x4*)(Z + (size_t)row * 4096 + 2048) + c.lane;
        float v[32]; float s = 0.f;
#pragma unroll
        for (int j = 0; j < 4; ++j) { const u32x4 q = zr[64 * j];
#pragma unroll
            for (int e = 0; e < 4; ++e) { v[j * 8 + 2 * e] = bflo(q[e]); v[j * 8 + 2 * e + 1] = bfhi(q[e]); s += v[j * 8 + 2 * e] + v[j * 8 + 2 * e + 1]; } }
        const float mean = wave_sum(s) * (1.f / 2048.f); float s2 = 0.f;
#pragma unroll
        for (int j = 0; j < 32; ++j) { const float dlt = v[j] - mean; s2 += dlt * dlt; }
        const float rstd = __builtin_amdgcn_rsqf(wave_sum(s2) * (1.f / 2048.f) + LN_EPS);
        if (c.lane == 0) { VSTAT[2 * row] = mean; VSTAT[2 * row + 1] = rstd; }
    }
}
__device__ __forceinline__ void gmlp_spatial(const Args& a, const Ctx& c, bf16_t* Z, const float* VSTAT, const bf16_t* WS16, bf16_t* dry = nullptr) {
    const int l15 = c.lane & 15, q4 = c.lane >> 4, w = c.wid;
    LAS bf16_t* VTL = (LAS bf16_t*)c.lds;
    const float* lg = AIN(I_GLNG); const float* lb = AIN(I_GLNB); const float* bs = AIN(I_GBS);
    u32x4 zpre[8];
#define SP_FETCH(IT) do { const int ch_ = (IT) >> 3, hh_ = (IT) & 7; _Pragma("unroll") for (int k = 0; k < 8; ++k) { const int i = c.tid + 512 * k; \
        zpre[k] = *(const u32x4*)(Z + (size_t)(ch_ * 128 + (i >> 5)) * 4096 + 2048 + 256 * hh_ + (i & 31) * 8); } } while (0)
    if (c.bid < 128 * 8) SP_FETCH(c.bid);
    for (int it = c.bid; it < 128 * 8; it += c.nb) {
        const int ch = it >> 3, hh = it & 7;
        __syncthreads();
#pragma unroll
        for (int k = 0; k < 8; ++k) { const int i = c.tid + 512 * k; const int q = i >> 5, c8 = (i & 31) * 8; const int row = ch * 128 + q;
            const u32x4 zv = zpre[k];
            const float mean = VSTAT[2 * row] * (1.f / 2048.f), rstd = __builtin_amdgcn_rsqf(fmaxf(VSTAT[2 * row + 1] * (1.f / 2048.f) - mean * mean, 0.f) + LN_EPS);
#pragma unroll
            for (int e = 0; e < 4; ++e) { const int cc = c8 + 2 * e; const int gc = 256 * hh + cc;
                const float v0 = (bflo(zv[e]) - mean) * rstd * lg[gc] + lb[gc], v1 = (bfhi(zv[e]) - mean) * rstd * lg[gc + 1] + lb[gc + 1];
                VTL[cc * 136 + q] = (bf16_t)f2bf(v0); VTL[(cc + 1) * 136 + q] = (bf16_t)f2bf(v1); } }
        __syncthreads();
        if (it + c.nb < 128 * 8) SP_FETCH(it + c.nb);
        bf16x8 WF[4];
#pragma unroll
        for (int ks = 0; ks < 4; ++ks) WF[ks] = *(const bf16x8*)(WS16 + ((size_t)hh * 128 + 16 * w + l15) * 128 + 32 * ks + 8 * q4);
        const float bsp = bs[hh * 128 + 16 * w + l15];
        const size_t row = (size_t)ch * 128 + 16 * w + l15;
        u32x2 upre[16];
#pragma unroll
        for (int cb = 0; cb < 16; ++cb) upre[cb] = *(const u32x2*)(Z + row * 4096 + 256 * hh + 16 * cb + 4 * q4);
#pragma unroll
        for (int cb = 0; cb < 16; ++cb) {
            f32x4 acc = (f32x4){0.f, 0.f, 0.f, 0.f};
#pragma unroll
            for (int ks = 0; ks < 4; ++ks) { const bf16x8 vf = *(const LAS bf16x8*)(VTL + (16 * cb + l15) * 136 + 32 * ks + 8 * q4); acc = mfma16(vf, WF[ks], acc); }
            bf16_t* up = Z + row * 4096 + 256 * hh + 16 * cb + 4 * q4;
            const u32x2 uv = upre[cb];
            u32x2 ov; ov.x = pk2(bflo(uv.x) * (acc[0] + bsp), bfhi(uv.x) * (acc[1] + bsp)); ov.y = pk2(bflo(uv.y) * (acc[2] + bsp), bfhi(uv.y) * (acc[3] + bsp));
            if (dry) *(u32x2*)(dry + row * 2048 + 256 * hh + 16 * cb + 4 * q4) = ov; else *(u32x2*)up = ov;
        }
    }
#undef SP_FETCH
    __syncthreads();
}

#define ws ((unsigned char*)kargs()->ws)
#define MODS ((float*)(ws + WS_MODS))
#define RESL ((float*)kargs()->out)
#define RESC ((float*)(ws + WS_RESC))
#define H ((bf16_t*)(ws + WS_H))
#define ABUF ((bf16_t*)(ws + WS_ABUF))
#define HID ((bf16_t*)(ws + WS_HID))
#define WUP ((bf16_t*)(ws + WS_WUP))
#define WDN ((bf16_t*)(ws + WS_WDN))
#ifndef EXPM
#define EXPM 0
#endif
#define WS_PART (WS_ABUF + (size_t)128 * 1024 * 1024)
#define GEMM_SPLITK(Eobj, Ap, Bp, K_, lda_, ldb_) do { pg8::Gemm g_{Ap, Bp, 1024, 1024 * ((K_) / 256), 256, lda_, ldb_, 256, 2, 3, 256}; pg8::StaticOrder S_; S_.init(1024, 1024 * ((K_) / 256), c.nb, c.bid); FRESH(); pg8::gemm_phase<EpiAtomic>(c.lds, g_, S_, Eobj, c.tid); } while (0)
#define FRESH() do { int t_ = threadIdx.x; asm volatile("" : "+v"(t_)); int b_ = blockIdx.x; asm volatile("" : "+s"(b_)); int n_ = gridDim.x; asm volatile("" : "+s"(n_)); c.tid = t_; c.lane = t_ & 63; c.wid = __builtin_amdgcn_readfirstlane(t_ >> 6); c.bid = b_; c.nb = n_; c.gw = b_ * 8 + c.wid; c.ngw = n_ * 8; } while (0)
#define GSYNC() do { XcdBarrier xb_; xb_.bar = (unsigned*)(ws + WS_BAR); xb_.x = xb_xcc_id(); xb_.st = (volatile LAS unsigned*)(c.lds + 135168); xcd_barrier(xb_); if (EXPM & 8) xcd_barrier(xb_); FRESH(); } while (0)
#define REP2(bit, stmt) do { stmt; if (EXPM & (bit)) { FRESH(); stmt; } } while (0)
#define GEMM(EpiT, Eobj, Ap, Bp, M_, N_, K_, lda_, ldb_, apn_) do { pg8::Gemm g_{Ap, Bp, M_, N_, K_, lda_, ldb_, apn_, 0, 0x7fffffff, 0}; pg8::StaticOrder S_; S_.init(M_, (N_), c.nb, c.bid); FRESH(); pg8::gemm_phase<EpiT>(c.lds, g_, S_, Eobj, c.tid); } while (0)

#define LNSTAT(pt) ((float*)(ws + WS_LNSTAT) + (size_t)(pt) * TL * 2)
#define LNCNT(pt) ((unsigned*)(ws + WS_LNCNT) + (size_t)(pt) * 64 * 64)
template <int layer> __device__ __forceinline__ void run_layer(const Args& a, Ctx& c) {
        const float* mods = MODS + layer * 5 * 6144;
        const int Mrows = layer < 2 ? TA : TL;
        if (layer == 0) {
            pool_mix(a, c, mods, HID);
            GSYNC();
            EpiResLn E{RESL, mods, MOD_GT1, AIN(I_LN1G) + layer * D, AIN(I_LN1B) + layer * D, H, mods, MOD_SH2, MOD_SC2, LNSTAT(0), LNCNT(0), 0, AIN(I_X), AIN(I_POOLB), AIN(I_POOLS)};
            GEMM(EpiResLn, E, HID, (const bf16_t*)(ws + WS_WPOOL), TL, 1024, 256, 1024, 256, 256);
            { EpiRes<0> Ec{AIN(I_X), AIN(I_CTX), RESL, RESC, mods, MOD_GT1, AIN(I_POOLB), AIN(I_POOLS), TL};
              GEMM(EpiRes<0>, Ec, HID + (size_t)TL * D, (const bf16_t*)(ws + WS_WPOOL), 1024, 1024, 256, 1024, 256, 256); }
            GSYNC();
            ln_pass(c, TL, TA, RESL, RESC, AIN(I_LN1G) + layer * D, AIN(I_LN1B) + layer * D, H, mods, MOD_SH2, MOD_SC2, nullptr, 0, mods, MOD_GT1);
            GSYNC();
        } else if (layer == 1) {
            EpiRope E{(bf16_t*)(ws + WS_QK), (bf16_t*)(ws + WS_VT), (const float*)(ws + WS_ROPE)};
            GEMM(EpiRope, E, H, (const bf16_t*)(ws + WS_WQKV), TA, 1536, 1024, 1024, 1024, 0);
            GSYNC();
            attn_phase(a, c, (const bf16_t*)(ws + WS_QK), (const bf16_t*)(ws + WS_VT), HID);
            GSYNC();
            EpiResLn E2{RESL, mods, MOD_GT1, AIN(I_LN1G) + layer * D, AIN(I_LN1B) + layer * D, H, mods, MOD_SH2, MOD_SC2, LNSTAT(2 * layer), LNCNT(2 * layer), 0, RESL, nullptr, nullptr};
            GEMM(EpiResLn, E2, HID, (const bf16_t*)(ws + WS_WO), TL, 1024, 1024, 1024, 1024, 0);
            { EpiAtomic Ea{(float*)(ws + WS_PART)}; GEMM_SPLITK(Ea, HID + (size_t)TL * D, (const bf16_t*)(ws + WS_WO), 1024, 1024, 1024); }
            GSYNC();
            ln_pass(c, TL, TA, RESL, RESC, AIN(I_LN1G) + layer * D, AIN(I_LN1B) + layer * D, H, mods, MOD_SH2, MOD_SC2, (const float*)(ws + WS_PART), 4, mods, MOD_GT1);
            GSYNC();
        } else if (layer == 2) {
            ssm_s1(c, H, (const bf16_t*)(ws + WS_ET), (float*)(ws + WS_SLOC));
            GSYNC();
            ssm_s3(a, c, H, (const bf16_t*)(ws + WS_KK), (const bf16_t*)(ws + WS_GT), (const float*)(ws + WS_SLOC), (const f32x2*)(ws + WS_LAML), (bf16_t*)(ws + WS_GACT));
            GSYNC();
            { EpiGluLn E{RESL, mods, MOD_GT1, AIN(I_LN1G) + layer * D, AIN(I_LN1B) + layer * D, H, mods, MOD_SH2, MOD_SC2, LNSTAT(2 * layer), LNCNT(2 * layer)};
#pragma unroll 1
              for (int r = 0; r < 2; ++r) { pg8::Gemm g_{(const bf16_t*)(ws + WS_GACT), (const bf16_t*)(ws + WS_WGLU), TL, 2048, 1024, 1024, 1024, 0, 0, 0x7fffffff, 0};
                FRESH(); pg8::StaticOrder S_; S_.init(TL, 2048, c.nb, c.bid); S_.fixed_pm = 32 * r + (c.bid >> 3); S_.fixed_pn = c.bid & 7;
                pg8::gemm_phase<EpiGluLn>(c.lds, g_, S_, E, c.tid); } }
            GSYNC();
        } else {
            conv_weight(c, AIN(I_WUP) + (size_t)layer * 1024 * F2, 1024, F2, WUP, 0);
            conv_weight(c, AIN(I_WDN) + (size_t)layer * FH * 1024, FH, 1024, WDN, 0);
            __syncthreads();
            EpiBf16<2> E{ABUF, 4096, AIN(I_GBIN), (float*)(ws + WS_VSTAT)};
            GEMM(EpiBf16<2>, E, H, (const bf16_t*)(ws + WS_WGIN), TL, 4096, 1024, 1024, 1024, 0);
            GSYNC();
            gmlp_spatial(a, c, ABUF, (const float*)(ws + WS_VSTAT), (const bf16_t*)(ws + WS_WS16));
            GSYNC();
            EpiResLn E2{RESL, mods, MOD_GT1, AIN(I_LN1G) + layer * D, AIN(I_LN1B) + layer * D, H, mods, MOD_SH2, MOD_SC2, LNSTAT(2 * layer), LNCNT(2 * layer), 0, RESL, nullptr, nullptr};
            GEMM(EpiResLn, E2, ABUF, (const bf16_t*)(ws + WS_WGOUT), TL, 1024, 2048, 4096, 2048, 0);
            GSYNC();
        }
        { EpiBf16<0> E{ABUF, F2, nullptr, nullptr}; GEMM(EpiBf16<0>, E, H, WUP, Mrows, F2, 1024, 1024, 1024, 0); }
        GSYNC();
        conv_gate(c, Mrows, ABUF, HID, AIN(I_CONVW) + (size_t)layer * 3 * F2, AIN(I_CONVB) + (size_t)layer * F2);
        GSYNC();
        { EpiResLn E{RESL, mods, MOD_GT2, AIN(I_LN2G) + layer * D, AIN(I_LN2B) + layer * D, layer < 3 ? H : (bf16_t*)nullptr, mods + 5 * 6144, MOD_SH1, MOD_SC1, LNSTAT(2 * layer + 1), LNCNT(2 * layer + 1), layer == 1 ? 1 : 0, RESL, nullptr, nullptr};
          GEMM(EpiResLn, E, HID, WDN, TL, 1024, FH, FH, FH, 0); }
        if (layer < 2) { EpiAtomic Ea{(float*)(ws + WS_PART)}; GEMM_SPLITK(Ea, HID + (size_t)TL * FH, WDN, FH, FH, FH); }
        if (layer < 3) GSYNC();
        if (layer < 2) {
            ln_pass(c, TL, TA, RESL, RESC, AIN(I_LN2G) + layer * D, AIN(I_LN2B) + layer * D, H, mods + 5 * 6144, MOD_SH1, MOD_SC1, (const float*)(ws + WS_PART), 11, mods, MOD_GT2, layer == 1 ? 1 : 0);
            conv_weight(c, AIN(I_WUP) + (size_t)(layer + 1) * 1024 * F2, 1024, F2, WUP, 0);
            conv_weight(c, AIN(I_WDN) + (size_t)(layer + 1) * FH * 1024, FH, 1024, WDN, 0);
            if (layer == 1) ssm_tables(a, c);
            GSYNC();
        }
}

__global__ void __launch_bounds__(512) hidt_fwd(Args a) {
    extern __shared__ __attribute__((aligned(16))) unsigned char lds_raw[];
    cg::grid_group grid = cg::this_grid();
    Ctx c; c.tid = threadIdx.x; c.lane = c.tid & 63; c.wid = __builtin_amdgcn_readfirstlane(c.tid >> 6); c.bid = blockIdx.x; c.nb = gridDim.x;
    c.gw = c.bid * 8 + c.wid; c.ngw = c.nb * 8; c.lds = (LAS unsigned char*)lds_raw;

    if (c.bid == 0) for (int i = c.tid; i < XCD_BAR_WORDS; i += 512) ((unsigned*)(ws + WS_BAR))[i] = 0u;
    if (c.tid < 32) ((LAS unsigned*)(c.lds + 135168))[c.tid] = 0u;
    REP2(4, phase0(a, c));
    __syncthreads();
    grid.sync();
    (void)xcd_barrier_post((unsigned*)(ws + WS_BAR), (volatile LAS unsigned*)(c.lds + 135168));
    FRESH();
    run_layer<0>(a, c);
    run_layer<1>(a, c);
    run_layer<2>(a, c);
    run_layer<3>(a, c);
}

#undef ws
#undef MODS
#undef RESL
#undef RESC
#undef H
#undef ABUF
#undef HID
#undef WUP
#undef WDN
extern "C" void kernel_launch(void* const* d_in, const int* in_sizes, int n_in, void* d_out, int out_size, void* d_ws, size_t ws_size, hipStream_t stream) {
    static int grid = 0;
    if (grid == 0) {
        if (n_in != 37 || ws_size < WS_END) { fprintf(stderr, "kernel_launch: unexpected inputs (n_in %d, ws %zu, need %zu)\n", n_in, ws_size, (size_t)WS_END); grid = -1; return; }
        int dev = 0, cus = 0, per_cu = 0;
        (void)hipGetDevice(&dev);
        (void)hipDeviceGetAttribute(&cus, hipDeviceAttributeMultiprocessorCount, dev);
        if (hipFuncSetAttribute((const void*)hidt_fwd, hipFuncAttributeMaxDynamicSharedMemorySize, LDS_BYTES) != hipSuccess) { fprintf(stderr, "kernel_launch: hipFuncSetAttribute failed\n"); grid = -1; return; }
        if (hipOccupancyMaxActiveBlocksPerMultiprocessor(&per_cu, (const void*)hidt_fwd, 512, LDS_BYTES) != hipSuccess || per_cu < 1) { fprintf(stderr, "kernel_launch: occupancy query says %d\n", per_cu); per_cu = 1; }
        (void)hipGetLastError();
        grid = cus;
    }
    if (grid < 0) return;
    Args a{};
    for (int i = 0; i < 37; ++i) a.in[i] = (const float*)d_in[i];
    a.out = (float*)d_out; a.ws = (unsigned char*)d_ws;
    void* args[] = {&a};
    hipError_t e = hipLaunchCooperativeKernel((const void*)hidt_fwd, dim3(grid), dim3(512), args, LDS_BYTES, stream);
    if (e != hipSuccess) fprintf(stderr, "cooperative launch failed: %s (grid %d)\n", hipGetErrorString(e), grid);
}
```

```cpp
#include <hip/hip_runtime.h>
#include <hip/hip_cooperative_groups.h>
#include <cstdio>
namespace cg = cooperative_groups;

#define LAS __attribute__((address_space(3)))
typedef unsigned short bf16_t;
typedef short bf16x8 __attribute__((ext_vector_type(8)));
typedef float f32x4 __attribute__((ext_vector_type(4)));
typedef float f32x2 __attribute__((ext_vector_type(2)));
typedef unsigned u32x4 __attribute__((ext_vector_type(4)));
typedef unsigned u32x2 __attribute__((ext_vector_type(2)));

constexpr int D = 1024, TL = 16384, TA = 17408, SEQ = 4096, CTXL = 256, FH = 2816, F2 = 5632;
constexpr float ALPHA = 1.681792830507429f;
constexpr float LN_EPS = 1e-5f;
constexpr int MOD_SH1 = 0, MOD_SC1 = 1024, MOD_GT1 = 2048, MOD_SH2 = 3072, MOD_SC2 = 4096, MOD_GT2 = 5120;

constexpr size_t WS_MODS = 0;
constexpr size_t WS_ROPE = 512 * 1024;
constexpr size_t WS_LAML = WS_ROPE + 16 * 1024;
constexpr size_t WS_VSTAT = WS_LAML + 128 * 1024;
constexpr size_t WS_BAR = WS_VSTAT + 128 * 1024;
constexpr size_t WS_WUP = 1024 * 1024;
constexpr size_t WS_WDN = WS_WUP + (size_t)F2 * D * 2;
constexpr size_t WS_WPOOL = WS_WDN + (size_t)D * FH * 2;
constexpr size_t WS_WQKV = WS_WPOOL + (size_t)D * 256 * 2;
constexpr size_t WS_WO = WS_WQKV + (size_t)1536 * D * 2;
constexpr size_t WS_WGLU = WS_WO + (size_t)D * D * 2;
constexpr size_t WS_WGIN = WS_WGLU + (size_t)2048 * D * 2;
constexpr size_t WS_WGOUT = WS_WGIN + (size_t)4096 * D * 2;
constexpr size_t WS_WS16 = WS_WGOUT + (size_t)D * 2048 * 2;
constexpr size_t WS_KK = WS_WS16 + (size_t)8 * 128 * 128 * 2;
constexpr size_t WS_RESC = WS_KK + (size_t)64 * 128 * 256 * 2;
constexpr size_t WS_H = WS_RESC + (size_t)1024 * D * 4;
constexpr size_t WS_ABUF = WS_H + (size_t)TA * D * 2;
constexpr size_t WS_HID = WS_ABUF + (size_t)TA * F2 * 2;
constexpr size_t WS_LNSTAT = WS_HID + (size_t)TA * FH * 2;
constexpr size_t WS_LNCNT = WS_LNSTAT + (size_t)8 * TL * 2 * 4;
constexpr size_t WS_END = WS_LNCNT + (size_t)8 * 64 * 256;
constexpr size_t WS_QK = WS_ABUF;
constexpr size_t WS_VT = WS_ABUF + (size_t)TA * 1280 * 2;
constexpr size_t WS_ET = WS_ABUF;
constexpr size_t WS_GT = WS_ABUF + (size_t)2 * 64 * 128 * 1024 * 2;
constexpr size_t WS_SLOC = WS_HID;
constexpr size_t WS_SIN = WS_HID + (size_t)2 * 64 * 272 * 128 * 4;
constexpr size_t WS_GACT = WS_SIN + (size_t)2 * 64 * 272 * 128 * 2;
static_assert(WS_GACT + (size_t)TL * D * 2 <= WS_END, "ws map");

constexpr int LDS_BYTES = 163840;

__device__ __forceinline__ unsigned f2bf(float f) { unsigned u = __builtin_bit_cast(unsigned, f); return (u + 0x7fffu + ((u >> 16) & 1u)) >> 16; }
__device__ __forceinline__ unsigned pk2(float lo, float hi) { typedef float f2_t __attribute__((ext_vector_type(2))); typedef __bf16 b2_t __attribute__((ext_vector_type(2))); f2_t v = {lo, hi}; b2_t b = __builtin_convertvector(v, b2_t); return __builtin_bit_cast(unsigned, b); }
__device__ __forceinline__ float bflo(unsigned w) { return __builtin_bit_cast(float, w << 16); }
__device__ __forceinline__ float bfhi(unsigned w) { return __builtin_bit_cast(float, w & 0xffff0000u); }
__device__ __forceinline__ float sigmoidf_(float x) { return __builtin_amdgcn_rcpf(1.0f + __expf(-x)); }
__device__ __forceinline__ float siluf_(float x) { return x * __builtin_amdgcn_rcpf(1.0f + __expf(-x)); }
__device__ __forceinline__ float gelu_tanh(float x) { const float u = 0.7978845608028654f * (x + 0.044715f * x * x * x); return x * __builtin_amdgcn_rcpf(1.0f + __expf(-2.0f * u)); }
__device__ __forceinline__ float wave_sum(float v) {
#pragma unroll
    for (int o = 1; o < 64; o <<= 1) v += __shfl_xor(v, o);
    return v;
}
#define LDS_WAIT() asm volatile("s_waitcnt lgkmcnt(0)" ::: "memory")
__device__ __forceinline__ f32x4 mfma16(bf16x8 a, bf16x8 b, f32x4 c) { return __builtin_amdgcn_mfma_f32_16x16x32_bf16(a, b, c, 0, 0, 0); }

namespace pg8 {
constexpr int BM = 256, BK = 64, HALF = 128, HTB = HALF * BK * 2, STAGE_BYTES = 8 * HTB, NXCD = 8, WGM = 8;
__host__ __device__ __forceinline__ int lds_byte(int r, int c) { const int st = (r >> 4) * 2 + (c >> 5), rr = r & 15, cc = c & 31, ob = rr * 64 + cc * 2; return st * 1024 + (ob ^ (((ob >> 9) & 1) << 5)); }
__host__ __device__ __forceinline__ void stage_rc(int b, int& R, int& C) { const int st = b / 1024, sb = b % 1024, swz = sb ^ (((sb >> 9) & 1) << 5); R = (st >> 1) * 16 + swz / 64; C = (st & 1) * 32 + (swz % 64) / 2; }
__host__ __device__ __forceinline__ int perm32(int rho) { const int n = rho >> 4, i = rho & 15; return 8 * (i >> 2) + 4 * n + (i & 3); }
struct Unit { int pm, pn; };
struct Gemm { const bf16_t* A; const bf16_t* Bt; int M, N, K, lda, ldb, apn, pshift, pmask, bpn; };
struct StaticOrder {
    int nM, nN, nwg, G, c, fixed_pm, fixed_pn;
    __device__ void init(int M, int N, int G_, int c_) { nM = M / BM; nN = N / BM; nwg = nM * nN; G = G_; c = c_; fixed_pm = -1; fixed_pn = 0; }
    __device__ bool next(int i, Unit& u) const {
        if (fixed_pm >= 0) { if (i > 0) return false; u.pm = fixed_pm; u.pn = fixed_pn; return true; }
        const long L = (long)i * G + c; if (L >= nwg) return false;
        int wgid = (int)L; { const int q = nwg / NXCD, r = nwg % NXCD, xcd = wgid % NXCD, off = wgid / NXCD; wgid = (xcd < r ? xcd * (q + 1) : r * (q + 1) + (xcd - r) * q) + off; }
        const int nig = WGM * nN, gid = wgid / nig, fm = gid * WGM, gsz = (nM - fm) < WGM ? (nM - fm) : WGM;
        u.pm = fm + ((wgid % nig) % gsz); u.pn = (wgid % nig) / gsz; return true;
    }
};
__device__ __forceinline__ unsigned cvt_pk_bf16(float lo, float hi) { unsigned r; asm volatile("v_cvt_pk_bf16_f32 %0, %1, %2" : "=v"(r) : "v"(lo), "v"(hi)); return r; }

template <class Epi>
__device__ __forceinline__ void gemm_phase(LAS unsigned char* lds, const Gemm g, const StaticOrder& S, const Epi& E, const int tid) {
    const int wid = __builtin_amdgcn_readfirstlane(tid >> 6), lane = tid & 63, wr = wid >> 2, wc = wid & 3, fr = lane & 15, fq = lane >> 4;
    const int K = g.K, nt = K / BK;
    unsigned voffA[2], voffB[2];
#pragma unroll
    for (int i = 0; i < 2; ++i) { int R, C; stage_rc(tid * 16 + i * 8192, R, C); const int Rb = Epi::PERM ? ((R & ~31) + perm32(R & 31)) : R;
        voffA[i] = (unsigned)(R * g.lda + C) * 2u; voffB[i] = (unsigned)(Rb * g.ldb + C) * 2u; }
    const size_t kstep = (size_t)(BK * 2);
    const size_t hstepA = (size_t)HALF * g.lda * 2, hstepB = (size_t)HALF * g.ldb * 2;
    const unsigned ldsw = (unsigned)wid * 1024u;
    const int aoff = lds_byte(wr * 64 + fr, fq * 8), boff = lds_byte(wc * 32 + fr, fq * 8);
#define PG8_SA(b, h) (((b) * 2 + (h)) * HTB)
#define PG8_SB(b, h) ((4 + (b) * 2 + (h)) * HTB)
#define PG8_STAGE(bufoff, gbase, voff) do { _Pragma("unroll") for (int _i = 0; _i < 2; ++_i) \
        __builtin_amdgcn_global_load_lds((const unsigned*)((const char*)(gbase) + (voff)[_i]), (LAS unsigned*)(lds + (bufoff) + ldsw + _i * 8192), 16, 0, 0); } while (0)
#define PG8_LDA(dst, b, h) do { _Pragma("unroll") for (int m = 0; m < 4; ++m) _Pragma("unroll") for (int k = 0; k < 2; ++k) dst[m][k] = *(const LAS bf16x8*)(lds + PG8_SA(b, h) + aoff + m * 2048 + k * 1024); } while (0)
#define PG8_LDB(dst, b, h) do { _Pragma("unroll") for (int n = 0; n < 2; ++n) _Pragma("unroll") for (int k = 0; k < 2; ++k) dst[n][k] = *(const LAS bf16x8*)(lds + PG8_SB(b, h) + boff + n * 2048 + k * 1024); } while (0)
#define PG8_MMA(ai, bj, At, Bt) do { __builtin_amdgcn_s_setprio(1); _Pragma("unroll") for (int m = 0; m < 4; ++m) _Pragma("unroll") for (int n = 0; n < 2; ++n) _Pragma("unroll") for (int k = 0; k < 2; ++k) \
        acc[ai][bj][m][n] = __builtin_amdgcn_mfma_f32_16x16x32_bf16(Bt[n][k], At[m][k], acc[ai][bj][m][n], 0, 0, 0); __builtin_amdgcn_s_setprio(0); } while (0)
#define PG8_WAIT_V(n) asm volatile("s_waitcnt vmcnt(" #n ")" ::: "memory")
#define PG8_WAIT_L(n) asm volatile("s_waitcnt lgkmcnt(" #n ")" ::: "memory")
#define PG8_BAR __builtin_amdgcn_s_barrier()
#define PG8_SCHED __builtin_amdgcn_sched_barrier(0)
    Unit cur, nxt; int ui = 0;
    if (!S.next(0, cur)) return;
    f32x4 acc[2][2][4][2];
#pragma unroll
    for (int a = 0; a < 2; ++a)
#pragma unroll
        for (int b = 0; b < 2; ++b)
#pragma unroll
            for (int m = 0; m < 4; ++m)
#pragma unroll
                for (int n = 0; n < 2; ++n) acc[a][b][m][n] = (f32x4){0.f, 0.f, 0.f, 0.f};
    bf16x8 At[4][2], B0[2][2], B1[2][2];
    const char* cA = (const char*)g.A + (size_t)cur.pm * 2 * hstepA + (size_t)(cur.pn >> g.pshift) * g.apn * 2; const char* cB = (const char*)g.Bt + (size_t)(cur.pn & g.pmask) * 2 * hstepB + (size_t)(cur.pn >> g.pshift) * g.bpn * 2;
    PG8_STAGE(PG8_SB(0, 0), cB, voffB); PG8_STAGE(PG8_SA(0, 0), cA, voffA); PG8_STAGE(PG8_SB(0, 1), cB + hstepB, voffB); PG8_STAGE(PG8_SA(0, 1), cA + hstepA, voffA);
    if (wr == 1) PG8_BAR;
    PG8_WAIT_V(4); PG8_BAR;
    PG8_STAGE(PG8_SB(1, 0), cB + kstep, voffB); PG8_STAGE(PG8_SA(1, 0), cA + kstep, voffA); PG8_STAGE(PG8_SB(1, 1), cB + hstepB + kstep, voffB);
    PG8_WAIT_V(6); PG8_BAR;
    for (;;) {
        const bool has_next = S.next(ui + 1, nxt);
        const char* nA = has_next ? (const char*)g.A + (size_t)nxt.pm * 2 * hstepA + (size_t)(nxt.pn >> g.pshift) * g.apn * 2 : cA; const char* nB = has_next ? (const char*)g.Bt + (size_t)(nxt.pn & g.pmask) * 2 * hstepB + (size_t)(nxt.pn >> g.pshift) * g.bpn * 2 : cB;
        for (int t = 0; t < nt; t += 2) {
            const bool last = (t == nt - 2);
            const char* a1 = cA + (size_t)(t + 1) * kstep;
            const char* a2 = last ? nA : cA + (size_t)(t + 2) * kstep; const char* b2 = last ? nB : cB + (size_t)(t + 2) * kstep;
            const char* a3 = a2 + kstep; const char* b3 = b2 + kstep;
            PG8_LDB(B0, 0, 0); PG8_SCHED; PG8_LDA(At, 0, 0); PG8_STAGE(PG8_SA(1, 1), a1 + hstepA, voffA);
            PG8_WAIT_L(8); PG8_BAR; PG8_WAIT_L(0); PG8_MMA(0, 0, At, B0); PG8_BAR; PG8_SCHED;
            PG8_LDB(B1, 0, 1); PG8_STAGE(PG8_SB(0, 0), b2, voffB);
            PG8_BAR; PG8_WAIT_L(0); PG8_MMA(0, 1, At, B1); PG8_BAR;
            PG8_LDA(At, 0, 1); PG8_STAGE(PG8_SA(0, 0), a2, voffA);
            PG8_BAR; PG8_WAIT_L(0); PG8_MMA(1, 0, At, B0); PG8_BAR; PG8_SCHED;
            PG8_STAGE(PG8_SB(0, 1), b2 + hstepB, voffB);
            PG8_WAIT_V(6); PG8_BAR; PG8_MMA(1, 1, At, B1); PG8_BAR;
            PG8_LDB(B0, 1, 0); PG8_SCHED; PG8_LDA(At, 1, 0); PG8_STAGE(PG8_SA(0, 1), a2 + hstepA, voffA);
            PG8_WAIT_L(8); PG8_BAR; PG8_WAIT_L(0); PG8_MMA(0, 0, At, B0); PG8_BAR; PG8_SCHED;
            PG8_LDB(B1, 1, 1); PG8_STAGE(PG8_SB(1, 0), b3, voffB);
            PG8_BAR; PG8_WAIT_L(0); PG8_MMA(0, 1, At, B1); PG8_BAR;
            PG8_LDA(At, 1, 1); PG8_STAGE(PG8_SA(1, 0), a3, voffA);
            PG8_BAR; PG8_WAIT_L(0); PG8_MMA(1, 0, At, B0); PG8_BAR; PG8_SCHED;
            PG8_STAGE(PG8_SB(1, 1), b3 + hstepB, voffB);
            PG8_WAIT_V(6); PG8_BAR; PG8_MMA(1, 1, At, B1); PG8_BAR;
        }
        if constexpr (!Epi::AFTER_DRAIN) E(acc, cur, wr, wc, fr, fq);
        if (!has_next) break;
#pragma unroll
        for (int a = 0; a < 2; ++a)
#pragma unroll
            for (int b = 0; b < 2; ++b)
#pragma unroll
                for (int m = 0; m < 4; ++m)
#pragma unroll
                    for (int n = 0; n < 2; ++n) acc[a][b][m][n] = (f32x4){0.f, 0.f, 0.f, 0.f};
        cur = nxt; cA = nA; cB = nB; ++ui;
    }
    PG8_WAIT_V(0);
    if (wr == 0) PG8_BAR;
    PG8_BAR;
    if constexpr (Epi::AFTER_DRAIN) E.fused(acc, cur, wr, wc, fr, fq, lds, tid);
#undef PG8_SA
#undef PG8_SB
#undef PG8_STAGE
#undef PG8_LDA
#undef PG8_LDB
#undef PG8_MMA
#undef PG8_WAIT_V
#undef PG8_WAIT_L
#undef PG8_BAR
#undef PG8_SCHED
}
}

template <int ACT  > struct EpiBf16 {
    static constexpr bool PERM = true, AFTER_DRAIN = false;
    bf16_t* O; int ldc; const float* bias; float* stat;
    __device__ __forceinline__ void operator()(const f32x4 (&acc)[2][2][4][2], const pg8::Unit& u, int wr, int wc, int fr, int fq) const {
        asm volatile("" : "+v"(fr), "+v"(fq));
        const int row0 = u.pm * 256 + wr * 64 + fr, col0 = u.pn * 256 + wc * 32 + 8 * fq;
#pragma unroll
        for (int ai = 0; ai < 2; ++ai)
#pragma unroll
            for (int m = 0; m < 4; ++m) { bf16_t* rowp = O + (size_t)(row0 + ai * 128 + m * 16) * ldc + col0;
                float ssum = 0.f, ssq = 0.f;
#pragma unroll
                for (int bj = 0; bj < 2; ++bj) { f32x4 v0 = acc[ai][bj][m][0], v1 = acc[ai][bj][m][1];
                    if (ACT >= 1) { const f32x4 b0 = *(const f32x4*)(bias + col0 + bj * 128), b1 = *(const f32x4*)(bias + col0 + bj * 128 + 4);
#pragma unroll
                        for (int j = 0; j < 4; ++j) { v0[j] = gelu_tanh(v0[j] + b0[j]); v1[j] = gelu_tanh(v1[j] + b1[j]); } }
                    u32x4 w; w.x = pg8::cvt_pk_bf16(v0[0], v0[1]); w.y = pg8::cvt_pk_bf16(v0[2], v0[3]); w.z = pg8::cvt_pk_bf16(v1[0], v1[1]); w.w = pg8::cvt_pk_bf16(v1[2], v1[3]);
                    if (ACT == 2) {
#pragma unroll
                        for (int j = 0; j < 4; ++j) { ssum += v0[j] + v1[j]; ssq += v0[j] * v0[j] + v1[j] * v1[j]; } }
                    *(u32x4*)(rowp + bj * 128) = w; }
                if (ACT == 2 && u.pn >= 8) { ssum += __shfl_xor(ssum, 16); ssum += __shfl_xor(ssum, 32); ssq += __shfl_xor(ssq, 16); ssq += __shfl_xor(ssq, 32);
                    if (fq == 0) { float* sp = stat + 2 * (size_t)(row0 + ai * 128 + m * 16);
                        (void)__hip_atomic_fetch_add(sp, ssum, __ATOMIC_RELAXED, __HIP_MEMORY_SCOPE_AGENT); (void)__hip_atomic_fetch_add(sp + 1, ssq, __ATOMIC_RELAXED, __HIP_MEMORY_SCOPE_AGENT); } } }
    }
};
template <int GLU> struct EpiRes {
    static constexpr bool PERM = false, AFTER_DRAIN = false;
    const float* xin_lat; const float* xin_ctx; float* out_lat; float* out_ctx; const float* mods; int gate_off; const float* bias; const float* scale; int row_base;
    __device__ __forceinline__ void operator()(const f32x4 (&acc)[2][2][4][2], const pg8::Unit& u, int wr, int wc, int fr, int fq) const {
        asm volatile("" : "+v"(fr), "+v"(fq));
        const int rowt = u.pm * 256 + row_base; const bool isctx = rowt >= TL; const int cond = isctx ? 4 : (rowt >> 12);
        const float* gate = mods + cond * 6144 + gate_off;
        const float* xi = isctx ? xin_ctx + (size_t)(rowt - TL) * D : xin_lat + (size_t)rowt * D;
        float* xo = isctx ? out_ctx + (size_t)(rowt - TL) * D : out_lat + (size_t)rowt * D;
        const int rl0 = wr * 64 + fr;
        if (GLU) {
            const int col0 = u.pn * 128 + wc * 32 + 4 * fq;
#pragma unroll
            for (int n = 0; n < 2; ++n) { const f32x4 g4 = *(const f32x4*)(gate + col0 + n * 16);
                f32x4 xv[8];
#pragma unroll
                for (int q = 0; q < 8; ++q) xv[q] = *(const f32x4*)(xi + (size_t)(rl0 + (q >> 2) * 128 + (q & 3) * 16) * D + col0 + n * 16);
#pragma unroll
                for (int q = 0; q < 8; ++q) { const int ai = q >> 2, m = q & 3; const size_t o = (size_t)(rl0 + ai * 128 + m * 16) * D + col0 + n * 16;
                    const f32x4 a = acc[ai][0][m][n], b = acc[ai][1][m][n]; f32x4 v;
#pragma unroll
                    for (int j = 0; j < 4; ++j) v[j] = ALPHA * xv[q][j] + g4[j] * (a[j] * sigmoidf_(b[j]));
                    *(f32x4*)(xo + o) = v; } }
        } else {
            const int col0 = u.pn * 256 + wc * 32 + 4 * fq;
#pragma unroll
            for (int bj = 0; bj < 2; ++bj)
#pragma unroll
                for (int n = 0; n < 2; ++n) { const int c = col0 + bj * 128 + n * 16; const f32x4 g4 = *(const f32x4*)(gate + c);
                    f32x4 b4 = (f32x4){0.f, 0.f, 0.f, 0.f}, s4 = (f32x4){1.f, 1.f, 1.f, 1.f};
                    if (bias) { b4 = *(const f32x4*)(bias + c); s4 = *(const f32x4*)(scale + c); }
#pragma unroll
                    for (int hb = 0; hb < 2; ++hb) {
                        f32x4 xv[4];
#pragma unroll
                        for (int q = 0; q < 4; ++q) xv[q] = *(const f32x4*)(xi + (unsigned)(rl0 + hb * 128 + q * 16) * (unsigned)D + (unsigned)c);
                        __builtin_amdgcn_sched_barrier(0);
#pragma unroll
                        for (int q = 0; q < 4; ++q) { const f32x4 a = acc[hb][bj][q][n]; f32x4 v;
#pragma unroll
                            for (int j = 0; j < 4; ++j) v[j] = ALPHA * xv[q][j] + g4[j] * ((a[j] + b4[j]) * s4[j]);
                            *(f32x4*)(xo + (unsigned)(rl0 + hb * 128 + q * 16) * (unsigned)D + (unsigned)c) = v; }
                        asm volatile("" ::: "memory"); __builtin_amdgcn_sched_barrier(0); } }
        }
    }
};
struct EpiResLn {
    static constexpr bool PERM = false, AFTER_DRAIN = true;
    float* res; const float* mods; int gate_off; const float* lng; const float* lnb; bf16_t* Hout; const float* hmods; int sh_off, sc_off; float* stat; unsigned* cnt;
    int hgm;
    const float* xin; const float* bias; const float* scale;
    __device__ __forceinline__ void prefetch(const pg8::Unit& u, int tid, int wid, LAS unsigned char* lds) const {
        const int upm = __builtin_amdgcn_readfirstlane(u.pm), upn = __builtin_amdgcn_readfirstlane(u.pn);
        const float* base = xin + (size_t)upm * 256 * D + upn * 256;
#pragma unroll
        for (int k = 0; k < 4; ++k) { const int q = tid + 512 * k;
            __builtin_amdgcn_global_load_lds((const unsigned*)(base + (size_t)(q >> 3) * D + (q & 7) * 32), (LAS unsigned*)(lds + 157696 + wid * 256), 4, 0, 0); }
    }
    __device__ __forceinline__ void operator()(const f32x4 (&)[2][2][4][2], const pg8::Unit&, int, int, int, int) const {}
    __device__ __forceinline__ void fused(f32x4 (&acc)[2][2][4][2], const pg8::Unit& u, int wr, int wc, int fr, int fq, LAS unsigned char* lds, int tid) const {
        const int upm = __builtin_amdgcn_readfirstlane(u.pm), upn = __builtin_amdgcn_readfirstlane(u.pn);
        const int rowt = upm * 256, cond = rowt >> 12;
        const float* gate = mods + cond * 6144 + gate_off;
        float* xo = res + (size_t)rowt * D; bf16_t* ho = Hout + (size_t)rowt * D; const float* xi = xin + (size_t)rowt * D;
        const int rl0 = wr * 64 + fr, col0 = upn * 256 + wc * 32 + 4 * fq;
        LAS f32x2* P = (LAS f32x2*)lds;
        LAS f32x2* S = (LAS f32x2*)(lds + 8192);
#pragma unroll
        for (int bj = 0; bj < 2; ++bj)
#pragma unroll
            for (int n = 0; n < 2; ++n) { const int c = col0 + bj * 128 + n * 16; const f32x4 g4 = *(const f32x4*)(gate + c);
                f32x4 b4 = (f32x4){0.f, 0.f, 0.f, 0.f}, s4 = (f32x4){1.f, 1.f, 1.f, 1.f};
                if (bias) { b4 = *(const f32x4*)(bias + c); s4 = *(const f32x4*)(scale + c); }
#pragma unroll
                for (int hb = 0; hb < 2; ++hb) {
                    f32x4 xv[4];
#pragma unroll
                    for (int q = 0; q < 4; ++q) { const unsigned o = (unsigned)(rl0 + hb * 128 + q * 16) * (unsigned)D + (unsigned)c; xv[q] = *(const f32x4*)(xi + o); }
                    __builtin_amdgcn_sched_barrier(0);
#pragma unroll
                    for (int q = 0; q < 4; ++q) { acc[hb][bj][q][n] = ALPHA * xv[q] + g4 * ((acc[hb][bj][q][n] + b4) * s4); asm volatile("" : "+v"(acc[hb][bj][q][n])); }
                    asm volatile("" ::: "memory"); __builtin_amdgcn_sched_barrier(0); } }
#pragma unroll
        for (int ai = 0; ai < 2; ++ai)
#pragma unroll
            for (int m = 0; m < 4; ++m) { float s = 0.f, q = 0.f;
#pragma unroll
                for (int bj = 0; bj < 2; ++bj)
#pragma unroll
                    for (int n = 0; n < 2; ++n) { const f32x4 x = acc[ai][bj][m][n]; s += (x[0] + x[1]) + (x[2] + x[3]); q += (x[0] * x[0] + x[1] * x[1]) + (x[2] * x[2] + x[3] * x[3]); }
                s += __shfl_xor(s, 16); s += __shfl_xor(s, 32); q += __shfl_xor(q, 16); q += __shfl_xor(q, 32);
                if (fq == 0) P[(ai * 128 + wr * 64 + m * 16 + fr) * 4 + wc] = (f32x2){s, q}; }
        LDS_WAIT(); __syncthreads();
        if (tid < 256) { const f32x2 a = P[tid * 4 + 0], b = P[tid * 4 + 1], c2 = P[tid * 4 + 2], d = P[tid * 4 + 3];
            float* sp = stat + 2 * (size_t)(rowt + tid);
            const float r0 = __hip_atomic_fetch_add(sp, (a.x + b.x) + (c2.x + d.x), __ATOMIC_RELAXED, __HIP_MEMORY_SCOPE_AGENT);
            const float r1 = __hip_atomic_fetch_add(sp + 1, (a.y + b.y) + (c2.y + d.y), __ATOMIC_RELAXED, __HIP_MEMORY_SCOPE_AGENT);
            asm volatile("" :: "v"(r0), "v"(r1)); }
        asm volatile("s_waitcnt vmcnt(0)" ::: "memory");
        __syncthreads();
        if (tid == 0) { unsigned* cp = cnt + 64 * upm;
            (void)__hip_atomic_fetch_add(cp, 1u, __ATOMIC_RELAXED, __HIP_MEMORY_SCOPE_AGENT);
            unsigned sp_ = 0;
            while (__hip_atomic_load(cp, __ATOMIC_RELAXED, __HIP_MEMORY_SCOPE_AGENT) < 4u) { __builtin_amdgcn_s_sleep(2); if (++sp_ > (1u << 22)) break; } }
        __syncthreads();
        if (tid < 256) { const float* sp = stat + 2 * (size_t)(rowt + tid);
            const float s = __hip_atomic_load(sp, __ATOMIC_RELAXED, __HIP_MEMORY_SCOPE_AGENT), q = __hip_atomic_load(sp + 1, __ATOMIC_RELAXED, __HIP_MEMORY_SCOPE_AGENT);
            const float mean = s * (1.f / D), var = fmaxf(q * (1.f / D) - mean * mean, 0.f);
            S[tid] = (f32x2){mean, __builtin_amdgcn_rsqf(var + LN_EPS)}; }
        LDS_WAIT(); __syncthreads();
#pragma unroll
        for (int bj = 0; bj < 2; ++bj)
#pragma unroll
            for (int n = 0; n < 2; ++n) { const int c = col0 + bj * 128 + n * 16; const f32x4 lg4 = *(const f32x4*)(lng + c), lb4 = *(const f32x4*)(lnb + c);
                f32x4 sh4 = (f32x4){0.f, 0.f, 0.f, 0.f}, sc4 = sh4;
                if (Hout) { sh4 = *(const f32x4*)(hmods + cond * 6144 + sh_off + c); sc4 = 1.0f + *(const f32x4*)(hmods + cond * 6144 + sc_off + c); }
#pragma unroll
                for (int q = 0; q < 8; ++q) { const int ai = q >> 2, m = q & 3; const unsigned o = (unsigned)(rl0 + ai * 128 + m * 16) * (unsigned)D + (unsigned)c;
                    const f32x2 stq = S[ai * 128 + wr * 64 + m * 16 + fr];
                    const f32x4 x = (acc[ai][bj][m][n] - stq.x) * stq.y * lg4 + lb4;
                    *(f32x4*)(xo + o) = x;
                    if (Hout) { const f32x4 h = x * sc4 + sh4; u32x2 w; w.x = pk2(h[0], h[1]); w.y = pk2(h[2], h[3]);
                        if (hgm) *(u32x2*)(Hout + ((size_t)(c >> 4) * TA + rowt + rl0 + ai * 128 + m * 16) * 16 + (c & 15)) = w; else *(u32x2*)(ho + o) = w; } }
                asm volatile("" ::: "memory"); __builtin_amdgcn_sched_barrier(0); }
        LDS_WAIT(); __syncthreads();
    }
};
struct EpiGluLn {
    static constexpr bool PERM = false, AFTER_DRAIN = true;
    float* res; const float* mods; int gate_off; const float* lng; const float* lnb; bf16_t* Hout; const float* hmods; int sh_off, sc_off; float* stat; unsigned* cnt;
    __device__ __forceinline__ void prefetch(const pg8::Unit& u, int tid, int wid, LAS unsigned char* lds) const {
        const int upm = __builtin_amdgcn_readfirstlane(u.pm), upn = __builtin_amdgcn_readfirstlane(u.pn);
        const float* base = res + (size_t)upm * 256 * D + upn * 128;
#pragma unroll
        for (int k = 0; k < 2; ++k) { const int q = tid + 512 * k;
            __builtin_amdgcn_global_load_lds((const unsigned*)(base + (size_t)(q >> 2) * D + (q & 3) * 32), (LAS unsigned*)(lds + 157696 + wid * 256), 4, 0, 0); }
    }
    __device__ __forceinline__ void operator()(const f32x4 (&)[2][2][4][2], const pg8::Unit&, int, int, int, int) const {}
    __device__ __forceinline__ void fused(f32x4 (&acc)[2][2][4][2], const pg8::Unit& u, int wr, int wc, int fr, int fq, LAS unsigned char* lds, int tid) const {
        const int upm = __builtin_amdgcn_readfirstlane(u.pm), upn = __builtin_amdgcn_readfirstlane(u.pn);
        const int rowt = upm * 256, cond = rowt >> 12;
        const float* gate = mods + cond * 6144 + gate_off;
        float* xo = res + (size_t)rowt * D; bf16_t* ho = Hout + (size_t)rowt * D;
        const int rl0 = wr * 64 + fr, col0 = upn * 128 + wc * 32 + 4 * fq;
        LAS f32x2* P = (LAS f32x2*)lds; LAS f32x2* S = (LAS f32x2*)(lds + 8192);
#pragma unroll
        for (int n = 0; n < 2; ++n) { const int c = col0 + n * 16; const f32x4 g4 = *(const f32x4*)(gate + c);
#pragma unroll
            for (int hb = 0; hb < 2; ++hb) {
                f32x4 xv[4];
#pragma unroll
                for (int q = 0; q < 4; ++q) { const unsigned o = (unsigned)(rl0 + hb * 128 + q * 16) * (unsigned)D + (unsigned)c; xv[q] = *(const f32x4*)(xo + o); }
                __builtin_amdgcn_sched_barrier(0);
#pragma unroll
                for (int q = 0; q < 4; ++q) { const f32x4 a = acc[hb][0][q][n], b = acc[hb][1][q][n]; f32x4 v;
#pragma unroll
                    for (int j = 0; j < 4; ++j) v[j] = ALPHA * xv[q][j] + g4[j] * (a[j] * sigmoidf_(b[j]));
                    acc[hb][0][q][n] = v; asm volatile("" : "+v"(acc[hb][0][q][n])); }
                asm volatile("" ::: "memory"); __builtin_amdgcn_sched_barrier(0); } }
#pragma unroll
        for (int ai = 0; ai < 2; ++ai)
#pragma unroll
            for (int m = 0; m < 4; ++m) { float s = 0.f, q = 0.f;
#pragma unroll
                for (int n = 0; n < 2; ++n) { const f32x4 x = acc[ai][0][m][n]; s += (x[0] + x[1]) + (x[2] + x[3]); q += (x[0] * x[0] + x[1] * x[1]) + (x[2] * x[2] + x[3] * x[3]); }
                s += __shfl_xor(s, 16); s += __shfl_xor(s, 32); q += __shfl_xor(q, 16); q += __shfl_xor(q, 32);
                if (fq == 0) P[(ai * 128 + wr * 64 + m * 16 + fr) * 4 + wc] = (f32x2){s, q}; }
        LDS_WAIT(); __syncthreads();
        if (tid < 256) { const f32x2 a = P[tid * 4 + 0], b = P[tid * 4 + 1], c2 = P[tid * 4 + 2], d = P[tid * 4 + 3];
            float* sp = stat + 2 * (size_t)(rowt + tid);
            const float r0 = __hip_atomic_fetch_add(sp, (a.x + b.x) + (c2.x + d.x), __ATOMIC_RELAXED, __HIP_MEMORY_SCOPE_AGENT);
            const float r1 = __hip_atomic_fetch_add(sp + 1, (a.y + b.y) + (c2.y + d.y), __ATOMIC_RELAXED, __HIP_MEMORY_SCOPE_AGENT);
            asm volatile("" :: "v"(r0), "v"(r1)); }
        asm volatile("s_waitcnt vmcnt(0)" ::: "memory");
        __syncthreads();
        if (tid == 0) { unsigned* cp = cnt + 64 * upm;
            (void)__hip_atomic_fetch_add(cp, 1u, __ATOMIC_RELAXED, __HIP_MEMORY_SCOPE_AGENT);
            unsigned sp_ = 0;
            while (__hip_atomic_load(cp, __ATOMIC_RELAXED, __HIP_MEMORY_SCOPE_AGENT) < 8u) { __builtin_amdgcn_s_sleep(2); if (++sp_ > (1u << 22)) break; } }
        __syncthreads();
        if (tid < 256) { const float* sp = stat + 2 * (size_t)(rowt + tid);
            const float s = __hip_atomic_load(sp, __ATOMIC_RELAXED, __HIP_MEMORY_SCOPE_AGENT), q = __hip_atomic_load(sp + 1, __ATOMIC_RELAXED, __HIP_MEMORY_SCOPE_AGENT);
            const float mean = s * (1.f / D), var = fmaxf(q * (1.f / D) - mean * mean, 0.f);
            S[tid] = (f32x2){mean, __builtin_amdgcn_rsqf(var + LN_EPS)}; }
        LDS_WAIT(); __syncthreads();
#pragma unroll
        for (int n = 0; n < 2; ++n) { const int c = col0 + n * 16; const f32x4 lg4 = *(const f32x4*)(lng + c), lb4 = *(const f32x4*)(lnb + c);
            const f32x4 sh4 = *(const f32x4*)(hmods + cond * 6144 + sh_off + c), sc4 = 1.0f + *(const f32x4*)(hmods + cond * 6144 + sc_off + c);
#pragma unroll
            for (int q = 0; q < 8; ++q) { const int ai = q >> 2, m = q & 3; const unsigned o = (unsigned)(rl0 + ai * 128 + m * 16) * (unsigned)D + (unsigned)c;
                const f32x2 stq = S[ai * 128 + wr * 64 + m * 16 + fr];
                const f32x4 x = (acc[ai][0][m][n] - stq.x) * stq.y * lg4 + lb4;
                *(f32x4*)(xo + o) = x;
                const f32x4 h = x * sc4 + sh4; u32x2 w; w.x = pk2(h[0], h[1]); w.y = pk2(h[2], h[3]); *(u32x2*)(ho + o) = w; }
            asm volatile("" ::: "memory"); __builtin_amdgcn_sched_barrier(0); }
        LDS_WAIT(); __syncthreads();
    }
};
struct EpiAtomic {
    static constexpr bool PERM = false, AFTER_DRAIN = false;
    float* part;
    __device__ __forceinline__ void operator()(const f32x4 (&acc)[2][2][4][2], const pg8::Unit& u, int wr, int wc, int fr, int fq) const {
        asm volatile("" : "+v"(fr), "+v"(fq));
        const int row0 = u.pm * 256 + wr * 64 + fr, col0 = (u.pn & 3) * 256 + wc * 32 + 4 * fq;
        float* base = part + (size_t)(u.pn >> 2) * 1024 * 1024;
#pragma unroll
        for (int ai = 0; ai < 2; ++ai)
#pragma unroll
            for (int m = 0; m < 4; ++m) { float* o = base + (size_t)(row0 + ai * 128 + m * 16) * D + col0;
#pragma unroll
                for (int bj = 0; bj < 2; ++bj)
#pragma unroll
                    for (int n = 0; n < 2; ++n) *(f32x4*)(o + bj * 128 + n * 16) = acc[ai][bj][m][n]; }
    }
};
struct EpiRope {
    static constexpr bool PERM = false, AFTER_DRAIN = false;
    bf16_t* QK; bf16_t* VT; const float* rope;
    __device__ __forceinline__ void operator()(const f32x4 (&acc)[2][2][4][2], const pg8::Unit& u, int wr, int wc, int fr, int fq) const {
        asm volatile("" : "+v"(fr), "+v"(fq));
        const int rowt = u.pm * 256; const bool isctx = rowt >= TL;
        const int rl0 = rowt + wr * 64 + fr;
        if (u.pn < 5) {
            const int colb = u.pn * 256 + wc * 32 + 4 * fq;
#pragma unroll
            for (int ai = 0; ai < 2; ++ai)
#pragma unroll
                for (int m = 0; m < 4; ++m) { const int r = rl0 + ai * 128 + m * 16; const int t = r & 4095; const int pos = (wc & 1) ? (t & 63) : (t >> 6);
                    f32x4 cs0 = (f32x4){1.f, 0.f, 1.f, 0.f}, cs1 = cs0;
                    if (!isctx) { cs0 = *(const f32x4*)(rope + (pos * 16 + 4 * fq) * 2); cs1 = *(const f32x4*)(rope + (pos * 16 + 4 * fq + 2) * 2); }
#pragma unroll
                    for (int bj = 0; bj < 2; ++bj) { const f32x4 x1 = acc[ai][bj][m][0], x2 = acc[ai][bj][m][1];
                        f32x4 o1, o2;
                        o1[0] = x1[0] * cs0[0] - x2[0] * cs0[1]; o2[0] = x1[0] * cs0[1] + x2[0] * cs0[0];
                        o1[1] = x1[1] * cs0[2] - x2[1] * cs0[3]; o2[1] = x1[1] * cs0[3] + x2[1] * cs0[2];
                        o1[2] = x1[2] * cs1[0] - x2[2] * cs1[1]; o2[2] = x1[2] * cs1[1] + x2[2] * cs1[0];
                        o1[3] = x1[3] * cs1[2] - x2[3] * cs1[3]; o2[3] = x1[3] * cs1[3] + x2[3] * cs1[2];
                        bf16_t* p = QK + (size_t)r * 1280 + colb + bj * 128;
                        u32x2 w1, w2; w1.x = pk2(o1[0], o1[1]); w1.y = pk2(o1[2], o1[3]); w2.x = pk2(o2[0], o2[1]); w2.y = pk2(o2[2], o2[3]);
                        *(u32x2*)p = w1; *(u32x2*)(p + 16) = w2; } }
        } else {
            const int colb = wc * 32 + 4 * fq;
#pragma unroll
            for (int ai = 0; ai < 2; ++ai)
#pragma unroll
                for (int m = 0; m < 4; ++m) { const int r = rl0 + ai * 128 + m * 16; const int k32 = r & 31; const int rp = (r & ~31) + 8 * ((k32 >> 2) & 3) + 4 * (k32 >> 4) + (k32 & 3);
#pragma unroll
                    for (int bj = 0; bj < 2; ++bj)
#pragma unroll
                        for (int n = 0; n < 2; ++n)
#pragma unroll
                            for (int j = 0; j < 4; ++j) VT[(size_t)(colb + bj * 128 + n * 16 + j) * TA + rp] = (bf16_t)f2bf(acc[ai][bj][m][n][j]); }
        }
    }
};


#define XB_TMO      128
#define XB_XCNT(j)  (256  + 64 * (j))
#define XB_XSUB(j)  (1280 + 64 * (j))
#define XB_XGEN(j)  (2304 + 64 * (j))
#define XB_TOP      3328
#define XB_TOPGEN   3392
#define XCD_BAR_WORDS 3456
#define XB_SPIN_CAP (1u << 22)
__device__ __forceinline__ unsigned xb_ld(unsigned* p)              { return __hip_atomic_load(p, __ATOMIC_RELAXED, __HIP_MEMORY_SCOPE_AGENT); }
__device__ __forceinline__ unsigned xb_add(unsigned* p, unsigned v) { return __hip_atomic_fetch_add(p, v, __ATOMIC_RELAXED, __HIP_MEMORY_SCOPE_AGENT); }
__device__ __forceinline__ unsigned xb_xcc_id() { return (unsigned)__builtin_amdgcn_s_getreg((3 << 11) | 20) & 0xFu; }
#define XB_SPIN(cond, bar) do { unsigned _sp = 0; while (cond) { __builtin_amdgcn_s_sleep(1); \
    if ((++_sp & 255u) == 0u) { if (xb_ld(&(bar)[XB_TMO])) break; if (_sp > XB_SPIN_CAP) { atomicAdd(&(bar)[XB_TMO], 1u); break; } } } } while (0)
struct XcdBarrier { unsigned* bar; unsigned x; volatile LAS unsigned* st; };
__device__ __forceinline__ XcdBarrier xcd_barrier_post(unsigned* bar, volatile LAS unsigned* st) {
    XcdBarrier b; b.bar = bar; b.x = xb_xcc_id(); b.st = st;
    if (threadIdx.x == 0) (void)xb_add(&bar[XB_XCNT(b.x)], 1u);
    return b;
}
__device__ __forceinline__ void xcd_barrier_complete(unsigned* bar, unsigned x, unsigned& nloc, unsigned& nx) {
    const unsigned G = gridDim.x * gridDim.y * gridDim.z;
    unsigned sum, cnt, mine, sp = 0u;
    for (;;) {
        sum = 0u; cnt = 0u; mine = 0u;
#pragma unroll
        for (unsigned j = 0; j < 16; ++j) { const unsigned c = xb_ld(&bar[XB_XCNT(j)]); sum += c; cnt += (c > 0u) ? 1u : 0u; mine = (j == x) ? c : mine; }
        if (sum == G) break;
        __builtin_amdgcn_s_sleep(1);
        if ((++sp & 255u) == 0u) { if (xb_ld(&bar[XB_TMO])) break; if (sp > XB_SPIN_CAP) { atomicAdd(&bar[XB_TMO], 1u); break; } }
    }
    nloc = mine > 0u ? mine : 1u; nx = cnt > 0u ? cnt : 1u;
}
__device__ __forceinline__ void xcd_barrier(const XcdBarrier& b) {
    asm volatile("s_waitcnt vmcnt(0)" ::: "memory");
    __syncthreads();
    if (threadIdx.x == 0) {
        unsigned* bar = b.bar;
        __builtin_amdgcn_s_waitcnt(0);
        unsigned nloc = b.st[0], nx = b.st[1];
        if (nloc == 0u) { xcd_barrier_complete(bar, b.x, nloc, nx); b.st[0] = nloc; b.st[1] = nx; }
        const unsigned old = xb_add(&bar[XB_XSUB(b.x)], 1u);
        const unsigned gen = old / nloc;
        if (old + 1u == (gen + 1u) * nloc) {
            __builtin_amdgcn_fence(__ATOMIC_RELEASE, "agent");
            asm volatile("s_waitcnt vmcnt(0)" ::: "memory");
            const unsigned og = xb_add(&bar[XB_TOP], 1u);
            const unsigned tg = og / nx;
            if (og + 1u == (tg + 1u) * nx) xb_add(&bar[XB_TOPGEN], 1u);
            else XB_SPIN(xb_ld(&bar[XB_TOPGEN]) == tg, bar);
            __builtin_amdgcn_fence(__ATOMIC_ACQUIRE, "agent");
            xb_add(&bar[XB_XGEN(b.x)], 1u);
            asm volatile("s_waitcnt vmcnt(0)" ::: "memory");
        } else {
            XB_SPIN(xb_ld(&bar[XB_XGEN(b.x)]) == gen, bar);
            __builtin_amdgcn_fence(__ATOMIC_ACQUIRE, "agent");
            asm volatile("s_waitcnt vmcnt(0)" ::: "memory");
        }
    }
    __syncthreads();
}

struct Args { const float* in[37]; float* out; unsigned char* ws; };
enum { I_X = 0, I_C, I_CTX, I_CCTX, I_ADAW, I_ADAB, I_LN1G, I_LN1B, I_LN2G, I_LN2B, I_WUP, I_CONVW, I_CONVB, I_WDN, I_POOLW, I_POOLB, I_POOLS,
       I_WQKV, I_WOUT, I_SINK, I_LRE, I_LIM, I_LDT, I_BRE, I_BIM, I_CRE, I_CIM, I_SSMD, I_GLUA, I_GLUB, I_GWIN, I_GBIN, I_GLNG, I_GLNB, I_GWS, I_GBS, I_GWOUT };

struct Ctx { int tid, lane, wid, bid, nb, gw, ngw; LAS unsigned char* lds; };
typedef const __attribute__((address_space(4))) Args* KArgsPtr;
__device__ __forceinline__ KArgsPtr kargs() { KArgsPtr p = (KArgsPtr)__builtin_amdgcn_kernarg_segment_ptr(); asm volatile("" : "+s"(p)); return p; }
#define AIN(i) ((const float*)(kargs()->in[i]))

__device__ __forceinline__ void conv_weight(const Ctx& c, const float* W, int K, int N, bf16_t* WT, int mode) {
    LAS float* scr = (LAS float*)(c.lds + c.wid * 16384);
    const int nblk = N / 32, nitems = (K / 64) * nblk, lane = c.lane;
    for (int it = c.gw; it < nitems; it += c.ngw) {
        const int kb = it / nblk, nbk = it % nblk, k0 = 64 * kb, n0 = 32 * nbk;
        const int d0 = mode == 0 ? n0 : ((n0 >> 7) * 256 + (n0 & 127) + (mode == 2 ? 128 : 0));
#pragma unroll 8
        for (int i = 0; i < 32; ++i) { const int kk = 2 * i + (lane >> 5); scr[kk * 33 + (lane & 31)] = __builtin_nontemporal_load(W + (size_t)(k0 + kk) * N + n0 + (lane & 31)); }
        LDS_WAIT();
        const int cc = lane & 7;
#pragma unroll
        for (int j = 0; j < 4; ++j) { const int n = (lane >> 3) + 8 * j; const LAS float* s = scr + (8 * cc) * 33 + n;
            u32x4 o; o.x = pk2(s[0 * 33], s[1 * 33]); o.y = pk2(s[2 * 33], s[3 * 33]); o.z = pk2(s[4 * 33], s[5 * 33]); o.w = pk2(s[6 * 33], s[7 * 33]);
            *(u32x4*)(WT + (size_t)(d0 + n) * K + k0 + 8 * cc) = o; }
        LDS_WAIT();
    }
}
__device__ __forceinline__ void conv_plain(const Ctx& c, const float* W, bf16_t* O, int n) {
    for (int i = (c.bid * 512 + c.tid) * 4; i < n; i += c.nb * 512 * 4) { const f32x4 v = *(const f32x4*)(W + i); u32x2 w; w.x = pk2(v[0], v[1]); w.y = pk2(v[2], v[3]); *(u32x2*)(O + i) = w; }
}

__device__ __forceinline__ void cpow(float lre, float lim, float dt, int n, float& re, float& im) {
    const float mag = __expf(lre * dt * (float)n);
    double rev = (double)lim * (double)dt * (double)n * 0.15915494309189535;
    rev -= __builtin_rint(rev);
    const float r = (float)rev;
    re = mag * __builtin_amdgcn_cosf(r); im = mag * __builtin_amdgcn_sinf(r);
}
__device__ __forceinline__ void ssm_load_params(const Args& a, int d, int g, int tid, LAS float* lam, LAS float* dtp, LAS f32x2* bb, LAS f32x2* cc) {
    const int dg = d * 64 + g;
    const float dt = __expf(AIN(I_LDT)[dg]);
    if (tid < 64) { lam[2 * tid] = AIN(I_LRE)[dg * 64 + tid]; lam[2 * tid + 1] = AIN(I_LIM)[dg * 64 + tid]; }
    if (tid == 0) dtp[0] = dt;
    for (int i = tid; i < 1024; i += 512) {
        const int p = i >> 4;
        const float lre = AIN(I_LRE)[dg * 64 + p], lim = AIN(I_LIM)[dg * 64 + p];
        const float x = lre * dt, y = lim * dt;
        float cr, ci; { double rev = (double)lim * (double)dt * 0.15915494309189535; rev -= __builtin_rint(rev); const float r = (float)rev; cr = __builtin_amdgcn_cosf(r); ci = __builtin_amdgcn_sinf(r); }
        const float em1 = expm1f(x), ex = em1 + 1.0f;
        const float cm1 = (fabsf(y) < 0.25f) ? (-0.5f * y * y + (1.0f / 24.0f) * y * y * y * y - (1.0f / 720.0f) * y * y * y * y * y * y) : (cr - 1.0f);
        const float nr = em1 * cr + cm1, ni = ex * ci;
        const float den = 1.0f / (lre * lre + lim * lim);
        const float qr = (nr * lre + ni * lim) * den, qi = (ni * lre - nr * lim) * den;
        const float br = AIN(I_BRE)[(size_t)dg * 1024 + i], bi = AIN(I_BIM)[(size_t)dg * 1024 + i];
        bb[i] = (f32x2){qr * br - qi * bi, qr * bi + qi * br};
        cc[i] = (f32x2){AIN(I_CRE)[(size_t)dg * 1024 + i], AIN(I_CIM)[(size_t)dg * 1024 + i]};
    }
}

__device__ __forceinline__ void phase0(const Args& a, const Ctx& c) {
    unsigned char* ws = a.ws;
    {
        LAS float* sc = (LAS float*)c.lds;
        LAS float* red = (LAS float*)(c.lds + 20480);
        for (int i = c.tid; i < 5 * 1024; i += 512) { const int cnd = i >> 10, k = i & 1023; const float v = cnd < 4 ? AIN(I_C)[cnd * 1024 + k] : AIN(I_CCTX)[k]; sc[i] = siluf_(v); }
        __syncthreads();
        const int cl = c.tid & 15, kg = c.tid >> 4;
        for (int it = c.bid; it < 4 * 96; it += c.nb) {
            const int layer = it / 96, col0 = (it % 96) * 64;
            const float* W = AIN(I_ADAW) + (size_t)layer * 1024 * 6144 + col0 + 4 * cl;
            f32x4 acc[5];
#pragma unroll
            for (int q = 0; q < 5; ++q) acc[q] = (f32x4){0.f, 0.f, 0.f, 0.f};
#pragma unroll 8
            for (int kk = 0; kk < 32; ++kk) { const int k = kg * 32 + kk; const f32x4 w = __builtin_nontemporal_load((const f32x4*)(W + (size_t)k * 6144));
#pragma unroll
                for (int q = 0; q < 5; ++q) { const float s = sc[q * 1024 + k]; acc[q] += w * s; } }
#pragma unroll
            for (int q = 0; q < 5; ++q) *(LAS f32x4*)(red + (kg * 5 + q) * 64 + 4 * cl) = acc[q];
            __syncthreads();
            if (c.tid < 320) { const int q = c.tid >> 6, col = c.tid & 63; float s = AIN(I_ADAB)[layer * 6144 + col0 + col];
                for (int k2 = 0; k2 < 32; ++k2) s += red[(k2 * 5 + q) * 64 + col];
                ((float*)(ws + WS_MODS))[(layer * 5 + q) * 6144 + col0 + col] = s; }
            __syncthreads();
        }
    }
    for (int i = c.bid * 512 + c.tid; i < 2 * TL; i += c.nb * 512) ((float*)(ws + WS_VSTAT))[i] = 0.f;
    for (int i = c.bid * 512 + c.tid; i < 8 * TL * 2 + 8 * 64 * 64; i += c.nb * 512) ((unsigned*)(ws + WS_LNSTAT))[i] = 0u;
    for (int i = c.bid * 512 + c.tid; i < 64 * 16; i += c.nb * 512) { const int pos = i >> 4, k = i & 15; const float f = exp2f(-(float)k * (13.287712379549449f / 16.0f)); float s, co; __sincosf((float)pos * f, &s, &co);
        ((float*)(ws + WS_ROPE))[2 * i] = co; ((float*)(ws + WS_ROPE))[2 * i + 1] = s; }
    {
        LAS float* lam = (LAS float*)c.lds;
        LAS float* dtp = lam + 256;
        LAS f32x2* bb = (LAS f32x2*)(c.lds + 2048);
        LAS f32x2* cc = bb + 2048;
        LAS f32x2* Q = cc + 2048;
        for (int it = c.bid; it < 64 * 8; it += c.nb) {
            const int g = it >> 3, sl = it & 7;
            __syncthreads();
            ssm_load_params(a, 0, g, c.tid, lam, dtp, bb, cc);
            ssm_load_params(a, 1, g, c.tid, lam + 128, dtp + 1, bb + 1024, cc + 1024);
            __syncthreads();
            for (int li = sl * 16; li < sl * 16 + 16 && li < 127; ++li) {
                float out = 0.f;
                for (int d = 0; d < 2; ++d) {
                    int tau; if (d == 0) { if (li < 63) continue; tau = li - 63; } else { if (li > 63) continue; tau = 63 - li; }
                    __syncthreads();
                    for (int i = c.tid; i < 1024; i += 512) { const int p = i & 63; float pr, pi; cpow(lam[d * 128 + 2 * p], lam[d * 128 + 2 * p + 1], dtp[d], tau, pr, pi);
                        const f32x2 cv = cc[d * 1024 + i]; Q[i] = (f32x2){cv.x * pr - cv.y * pi, cv.x * pi + cv.y * pr}; }
                    __syncthreads();
                    if (c.tid < 256) { const int cq = c.tid >> 4, cp = c.tid & 15;
                        for (int p = 0; p < 64; ++p) { const f32x2 q = Q[cq * 64 + p], b = bb[d * 1024 + p * 16 + cp]; out += q.x * b.x - q.y * b.y; } }
                }
                if (c.tid < 256) ((bf16_t*)(ws + WS_KK))[((size_t)(g * 127 + li)) * 256 + c.tid] = (bf16_t)f2bf(out);
            }
        }
        __syncthreads();
    }
    conv_weight(c, AIN(I_WUP), 1024, F2, (bf16_t*)(ws + WS_WUP), 0);
    conv_weight(c, AIN(I_WDN), FH, 1024, (bf16_t*)(ws + WS_WDN), 0);
    for (int g = 0; g < 4; ++g) conv_weight(c, AIN(I_POOLW) + g * 65536, 256, 256, (bf16_t*)(ws + WS_WPOOL) + g * 65536, 0);
    conv_weight(c, AIN(I_WQKV), 1024, 1536, (bf16_t*)(ws + WS_WQKV), 0);
    conv_weight(c, AIN(I_WOUT), 1024, 1024, (bf16_t*)(ws + WS_WO), 0);
    conv_weight(c, AIN(I_GLUA), 1024, 1024, (bf16_t*)(ws + WS_WGLU), 1);
    conv_weight(c, AIN(I_GLUB), 1024, 1024, (bf16_t*)(ws + WS_WGLU), 2);
    conv_weight(c, AIN(I_GWIN), 1024, 4096, (bf16_t*)(ws + WS_WGIN), 0);
    conv_weight(c, AIN(I_GWOUT), 2048, 1024, (bf16_t*)(ws + WS_WGOUT), 0);
    conv_plain(c, AIN(I_GWS), (bf16_t*)(ws + WS_WS16), 8 * 128 * 128);
}

__device__ __forceinline__ void ssm_tables(const Args& a, const Ctx& c) {
    unsigned char* ws = a.ws;
    LAS float* lam = (LAS float*)c.lds; LAS float* dtp = lam + 128;
    LAS f32x2* bb = (LAS f32x2*)(c.lds + 2048); LAS f32x2* cc = bb + 1024; LAS f32x2* P = cc + 1024;
    for (int it = c.bid; it < 128; it += c.nb) {
        const int d = it >> 6, g = it & 63;
        __syncthreads();
        ssm_load_params(a, d, g, c.tid, lam, dtp, bb, cc);
        __syncthreads();
        for (int i = c.tid; i < 65 * 64; i += 512) { const int n = i >> 6, p = i & 63; float pr, pi; cpow(lam[2 * p], lam[2 * p + 1], dtp[0], n, pr, pi); P[i] = (f32x2){pr, pi}; }
        __syncthreads();
        if (c.tid < 64) ((f32x2*)(ws + WS_LAML))[(d * 64 + g) * 64 + c.tid] = P[64 * 64 + c.tid];
        bf16_t* ET = (bf16_t*)(ws + WS_ET) + (size_t)(d * 64 + g) * 128 * 1024;
        for (int i = c.tid; i < 64 * 128; i += 512) {
            const int p = i >> 7, kg8 = i & 127, tp = kg8 >> 1, c0 = (kg8 & 1) * 8;
            const f32x2 pw = P[(d ? tp : 63 - tp) * 64 + p];
            float re[8], im[8];
#pragma unroll
            for (int j = 0; j < 8; ++j) { const f32x2 b = bb[p * 16 + c0 + j]; re[j] = pw.x * b.x - pw.y * b.y; im[j] = pw.x * b.y + pw.y * b.x; }
            u32x4 wr_, wi_; wr_.x = pk2(re[0], re[1]); wr_.y = pk2(re[2], re[3]); wr_.z = pk2(re[4], re[5]); wr_.w = pk2(re[6], re[7]);
            wi_.x = pk2(im[0], im[1]); wi_.y = pk2(im[2], im[3]); wi_.z = pk2(im[4], im[5]); wi_.w = pk2(im[6], im[7]);
            *(u32x4*)(ET + (size_t)(2 * p) * 1024 + kg8 * 8) = wr_; *(u32x4*)(ET + (size_t)(2 * p + 1) * 1024 + kg8 * 8) = wi_;
        }
        bf16_t* GT = (bf16_t*)(ws + WS_GT) + (size_t)(d * 64 + g) * 1024 * 128;
        for (int i = c.tid; i < 1024 * 16; i += 512) {
            const int n = i >> 4, p0 = (i & 15) * 4, t = n >> 4, cq = n & 15;
            float v[8];
#pragma unroll
            for (int j = 0; j < 4; ++j) { const f32x2 pw = P[(d ? 64 - t : t + 1) * 64 + p0 + j], cv = cc[cq * 64 + p0 + j]; v[2 * j] = cv.x * pw.x - cv.y * pw.y; v[2 * j + 1] = -(cv.x * pw.y + cv.y * pw.x); }
            u32x4 w; w.x = pk2(v[0], v[1]); w.y = pk2(v[2], v[3]); w.z = pk2(v[4], v[5]); w.w = pk2(v[6], v[7]);
            *(u32x4*)(GT + (size_t)n * 128 + 2 * p0) = w;
        }
    }
    __syncthreads();
}

__device__ __forceinline__ void ln_pass(const Ctx& c, int row_begin, int M, float* res_lat, float* res_ctx, const float* g, const float* b, bf16_t* H, const float* mods, int sh_off, int sc_off, const float* parts, int nks, const float* mods_gate, int gate_off, int hgm = 0) {
    float* const dry = nullptr;
    for (int row0 = row_begin + 2 * c.gw; row0 < M; row0 += 2 * c.ngw) {
        f32x4* xr[2]; f32x4 v[2][4]; float s[2];
#pragma unroll
        for (int r = 0; r < 2; ++r) { const int row = row0 + r; float* p = row < TL ? res_lat + (size_t)row * D : res_ctx + (size_t)(row - TL) * D; xr[r] = (f32x4*)p + c.lane;
#pragma unroll
            for (int j = 0; j < 4; ++j) v[r][j] = xr[r][64 * j];
        }
        if (parts != nullptr && row0 >= TL) {
            f32x4 ps[2][4];
#pragma unroll
            for (int r = 0; r < 2; ++r)
#pragma unroll
                for (int j = 0; j < 4; ++j) ps[r][j] = (f32x4){0.f, 0.f, 0.f, 0.f};
#pragma unroll 1
            for (int ks = 0; ks < nks; ++ks) {
                const f32x4* pr = (const f32x4*)(parts + (size_t)ks * 1024 * 1024 + (size_t)(row0 - TL) * D) + c.lane;
#pragma unroll
                for (int r = 0; r < 2; ++r)
#pragma unroll
                    for (int j = 0; j < 4; ++j) ps[r][j] += __builtin_nontemporal_load(pr + r * 256 + 64 * j);
            }
#pragma unroll
            for (int j = 0; j < 4; ++j) { const f32x4 g4 = *(const f32x4*)(mods_gate + 4 * 6144 + gate_off + 4 * c.lane + 256 * j);
#pragma unroll
                for (int r = 0; r < 2; ++r) v[r][j] = ALPHA * v[r][j] + g4 * ps[r][j]; }
        }
#pragma unroll
        for (int r = 0; r < 2; ++r) { s[r] = 0.f;
#pragma unroll
            for (int j = 0; j < 4; ++j) s[r] += (v[r][j][0] + v[r][j][1]) + (v[r][j][2] + v[r][j][3]); }
        float mean[2], rstd[2];
#pragma unroll
        for (int r = 0; r < 2; ++r) mean[r] = wave_sum(s[r]) * (1.f / D);
#pragma unroll
        for (int r = 0; r < 2; ++r) { float s2 = 0.f;
#pragma unroll
            for (int j = 0; j < 4; ++j) { v[r][j] = v[r][j] - mean[r]; s2 += (v[r][j][0] * v[r][j][0] + v[r][j][1] * v[r][j][1]) + (v[r][j][2] * v[r][j][2] + v[r][j][3] * v[r][j][3]); }
            s[r] = s2; }
#pragma unroll
        for (int r = 0; r < 2; ++r) rstd[r] = __builtin_amdgcn_rsqf(wave_sum(s[r]) * (1.f / D) + LN_EPS);
        const int cond = row0 < TL ? (row0 >> 12) : 4;
#pragma unroll
        for (int j = 0; j < 4; ++j) { const int col = 4 * c.lane + 256 * j; const f32x4 g4 = *(const f32x4*)(g + col), b4 = *(const f32x4*)(b + col);
            f32x4 sh = (f32x4){0.f, 0.f, 0.f, 0.f}, sc = sh;
            if (H) { sh = *(const f32x4*)(mods + cond * 6144 + sh_off + col); sc = 1.0f + *(const f32x4*)(mods + cond * 6144 + sc_off + col); }
#pragma unroll
            for (int r = 0; r < 2; ++r) { const int row = row0 + r;
                const f32x4 x = v[r][j] * rstd[r] * g4 + b4;
                if (dry) ((f32x4*)(dry + (size_t)row * D))[c.lane + 64 * j] = x; else xr[r][64 * j] = x;
                if (H) { const f32x4 h = x * sc + sh; u32x2 w; w.x = pk2(h[0], h[1]); w.y = pk2(h[2], h[3]);
                    if (hgm) *(u32x2*)(H + ((size_t)(col >> 4) * TA + row) * 16 + (col & 15)) = w; else *(u32x2*)(H + (size_t)row * D + col) = w; } } }
    }
}

template <int W> __device__ __forceinline__ void pool_rows(const float* __restrict__ src, int t0, int n, f32x4 sc1, bf16_t* __restrict__ dst) {
    f32x4 R[8 + W - 1];
#pragma unroll
    for (int q = 0; q < 8 + W - 1; ++q) { const int t = t0 - W / 2 + q; R[q] = (t >= 0 && t < n) ? *(const f32x4*)(src + (size_t)t * D) : (f32x4){0.f, 0.f, 0.f, 0.f}; }
#pragma unroll
    for (int i = 0; i < 8; ++i) {
        f32x4 s = R[i];
#pragma unroll
        for (int k = 1; k < W; ++k) s += R[i + k];
        const int t = t0 + i, lo = max(t - W / 2, 0), hi = min(t - W / 2 + W, n);
        const f32x4 mx = (s * __builtin_amdgcn_rcpf((float)(hi - lo)) - R[i + W / 2]) * sc1;
        u32x2 o; o.x = pk2(mx[0], mx[1]); o.y = pk2(mx[2], mx[3]);
        *(u32x2*)(dst + (size_t)i * D) = o;
    }
}
__device__ __forceinline__ void pool_mix(const Args& a, const Ctx& c, const float* mods0, bf16_t* MIX) {
    for (int item = c.bid * 512 + c.tid; item < (TA / 8) * 256; item += c.nb * 512) {
        const int row0 = (item >> 8) * 8, col = (item & 255) * 4, grp = col >> 8;
        const float* src; int t0, n, cond;
        if (row0 < TL) { t0 = row0 & 4095; n = SEQ; src = AIN(I_X) + (size_t)(row0 - t0) * D + col; cond = row0 >> 12; }
        else { const int rr = row0 - TL; t0 = rr & 255; n = CTXL; src = AIN(I_CTX) + (size_t)(rr - t0) * D + col; cond = 4; }
        const f32x4 sc1 = 1.0f + *(const f32x4*)(mods0 + cond * 6144 + MOD_SC1 + col);
        bf16_t* dst = MIX + (size_t)row0 * D + col;
        if (grp == 0) pool_rows<2>(src, t0, n, sc1, dst);
        else if (grp == 1) pool_rows<4>(src, t0, n, sc1, dst);
        else if (grp == 2) pool_rows<8>(src, t0, n, sc1, dst);
        else pool_rows<16>(src, t0, n, sc1, dst);
    }
}

struct CgRow { u32x4 v, g; };
__device__ __forceinline__ CgRow cg_load(const bf16_t* p, bool ok) { CgRow r; const u32x4 z = (u32x4){0u, 0u, 0u, 0u}; r.v = ok ? __builtin_nontemporal_load((const u32x4*)p) : z; r.g = ok ? __builtin_nontemporal_load((const u32x4*)(p + FH)) : z; return r; }
__device__ __forceinline__ void conv_gate(const Ctx& c, int M, const bf16_t* __restrict__ A, bf16_t* __restrict__ HID, const float* __restrict__ cw, const float* __restrict__ cb) {
    const int nitems = (M >> 4) * 352;
    for (int item = c.bid * 512 + c.tid; item < nitems; item += c.nb * 512) {
        const int chunk = item / 352, j = (item - chunk * 352) * 8, row0 = chunk * 16;
        int t0, n; if (row0 < TL) { t0 = row0 & 4095; n = SEQ; } else { t0 = (row0 - TL) & 255; n = CTXL; }
        f32x4 wv[3][2], wg[3][2], bv[2], bg[2];
#pragma unroll
        for (int tap = 0; tap < 3; ++tap)
#pragma unroll
            for (int h = 0; h < 2; ++h) { wv[tap][h] = *(const f32x4*)(cw + tap * F2 + j + 4 * h); wg[tap][h] = *(const f32x4*)(cw + tap * F2 + FH + j + 4 * h); }
#pragma unroll
        for (int h = 0; h < 2; ++h) { bv[h] = *(const f32x4*)(cb + j + 4 * h); bg[h] = *(const f32x4*)(cb + FH + j + 4 * h); }
        const bf16_t* ap = A + (size_t)row0 * F2 + j;
        CgRow R[5];
        R[0] = cg_load(ap - F2, t0 > 0);
#pragma unroll
        for (int q = 1; q < 5; ++q) R[q] = cg_load(ap + (size_t)(q - 1) * F2, true);
#pragma unroll
        for (int i = 0; i < 16; ++i) {
            const CgRow& P = R[i % 5]; const CgRow& C = R[(i + 1) % 5]; const CgRow& Nx = R[(i + 2) % 5];
            unsigned o[4];
#pragma unroll
            for (int q = 0; q < 4; ++q) {
                const int h = q >> 1, e = (q & 1) * 2;
                const float v0 = bv[h][e] + bflo(P.v[q]) * wv[0][h][e] + bflo(C.v[q]) * wv[1][h][e] + bflo(Nx.v[q]) * wv[2][h][e];
                const float v1 = bv[h][e + 1] + bfhi(P.v[q]) * wv[0][h][e + 1] + bfhi(C.v[q]) * wv[1][h][e + 1] + bfhi(Nx.v[q]) * wv[2][h][e + 1];
                const float g0 = bg[h][e] + bflo(P.g[q]) * wg[0][h][e] + bflo(C.g[q]) * wg[1][h][e] + bflo(Nx.g[q]) * wg[2][h][e];
                const float g1 = bg[h][e + 1] + bfhi(P.g[q]) * wg[0][h][e + 1] + bfhi(C.g[q]) * wg[1][h][e + 1] + bfhi(Nx.g[q]) * wg[2][h][e + 1];
                o[q] = pk2(v0 * siluf_(g0), v1 * siluf_(g1));
            }
            *(u32x4*)(HID + (size_t)(row0 + i) * FH + j) = (u32x4){o[0], o[1], o[2], o[3]};
            if (i + 4 <= 16) { const bool ok = (i + 4 < 16) || (t0 + 16 < n); R[i % 5] = cg_load(ap + (size_t)(i + 4) * F2, ok); }
        }
    }
}

constexpr int ANQ = 4;
__device__ __forceinline__ void att_load(bf16x8 (&KF)[2][2], bf16x8 (&VF)[4], const bf16_t* __restrict__ QK, const bf16_t* __restrict__ VT, int kr, int hk, int l15, int q4) {
#pragma unroll
    for (int kb = 0; kb < 2; ++kb)
#pragma unroll
        for (int ks = 0; ks < 2; ++ks) KF[kb][ks] = *(const bf16x8*)(QK + (size_t)(kr + 16 * kb + l15) * 1280 + 1024 + 64 * hk + 32 * ks + 8 * q4);
#pragma unroll
    for (int db = 0; db < 4; ++db) VF[db] = *(const bf16x8*)(VT + (size_t)(64 * hk + 16 * db + l15) * TA + kr + 8 * q4);
}
__device__ __forceinline__ void att_tile(const bf16x8 (&KF)[2][2], const bf16x8 (&VF)[4], const bf16x8 (&QF)[ANQ][2], f32x4 (&Oa)[ANQ][4], float (&mrun)[ANQ], float (&lrun)[ANQ],
                                         bool need_mask, int kpos0, int qoff, int l15, int q4) {
    const float C2 = 0.18033688011112042f;
#pragma unroll
    for (int qb = 0; qb < ANQ; ++qb) {
        f32x4 s[2];
#pragma unroll
        for (int kb = 0; kb < 2; ++kb) { s[kb] = mfma16(KF[kb][0], QF[qb][0], (f32x4){0.f, 0.f, 0.f, 0.f}); s[kb] = mfma16(KF[kb][1], QF[qb][1], s[kb]); }
        if (need_mask) { const int qpos = qoff + 16 * qb + l15;
#pragma unroll
            for (int kb = 0; kb < 2; ++kb)
#pragma unroll
                for (int j = 0; j < 4; ++j) { const int dlt = kpos0 + 16 * kb + 4 * q4 + j - qpos; if (dlt > 128 || dlt < -128) s[kb][j] = -1e30f; } }
        float mx = fmaxf(fmaxf(fmaxf(s[0][0], s[0][1]), fmaxf(s[0][2], s[0][3])), fmaxf(fmaxf(s[1][0], s[1][1]), fmaxf(s[1][2], s[1][3])));
        mx = fmaxf(mx, __shfl_xor(mx, 16)); mx = fmaxf(mx, __shfl_xor(mx, 32));
        if (__builtin_amdgcn_ballot_w64(mx > mrun[qb]) != 0ull) {
            const float mnew = fmaxf(mrun[qb], mx), corr = __builtin_amdgcn_exp2f((mrun[qb] - mnew) * C2);
            mrun[qb] = mnew; lrun[qb] *= corr;
#pragma unroll
            for (int db = 0; db < 4; ++db) Oa[qb][db] = Oa[qb][db] * corr;
        }
        const float nm = -mrun[qb] * C2;
        float p[8];
#pragma unroll
        for (int kb = 0; kb < 2; ++kb)
#pragma unroll
            for (int j = 0; j < 4; ++j) p[kb * 4 + j] = __builtin_amdgcn_exp2f(fmaf(s[kb][j], C2, nm));
        lrun[qb] += ((p[0] + p[1]) + (p[2] + p[3])) + ((p[4] + p[5]) + (p[6] + p[7]));
        u32x4 pw; pw.x = pk2(p[0], p[1]); pw.y = pk2(p[2], p[3]); pw.z = pk2(p[4], p[5]); pw.w = pk2(p[6], p[7]);
        const bf16x8 PF = __builtin_bit_cast(bf16x8, pw);
#pragma unroll
        for (int db = 0; db < 4; ++db) Oa[qb][db] = mfma16(VF[db], PF, Oa[qb][db]);
    }
}
__device__ __forceinline__ void attn_phase(const Args& a, const Ctx& c, const bf16_t* QK, const bf16_t* VT, bf16_t* O) {
    const int lane = c.lane, w = c.wid, l15 = lane & 15, q4 = lane >> 4;
    const float* sink = AIN(I_SINK);
    for (int it = c.bid; it < 512 + 32; it += c.nb) {
        int b, nbq, hk; const bool isctx = it >= 512;
        if (!isctx) { hk = it & 3; nbq = (it >> 2) & 31; b = it >> 7; }
        else { const int i2 = it - 512; hk = i2 & 3; nbq = (i2 >> 2) & 1; b = i2 >> 3; }
        const int hq = hk * 4 + (w >> 1);
        const int qoff = nbq * 128 + 64 * (w & 1);
        const int r0 = (isctx ? TL + b * CTXL : b * SEQ) + qoff;
        bf16x8 QF[ANQ][2];
#pragma unroll
        for (int qb = 0; qb < ANQ; ++qb)
#pragma unroll
            for (int ks = 0; ks < 2; ++ks) QF[qb][ks] = *(const bf16x8*)(QK + (size_t)(r0 + 16 * qb + l15) * 1280 + 64 * hq + 32 * ks + 8 * q4);
        f32x4 Oa[ANQ][4]; float mrun[ANQ], lrun[ANQ];
        const float sk = sink[hq] * 8.0f;
#pragma unroll
        for (int qb = 0; qb < ANQ; ++qb) { mrun[qb] = sk; lrun[qb] = (q4 == 0) ? 1.0f : 0.0f;
#pragma unroll
            for (int db = 0; db < 4; ++db) Oa[qb][db] = (f32x4){0.f, 0.f, 0.f, 0.f}; }
        int kp0 = 0, kp1 = 0;
        if (!isctx) { kp0 = max(0, 128 * (nbq - 1)); kp1 = min(SEQ, 128 * (nbq + 2)); kp0 = max(kp0, (qoff - 128) & ~31); kp1 = min(kp1, ((qoff + 63 + 128) & ~31) + 32); }
        const int nband = (kp1 - kp0) >> 5, nt = nband + 8;
        const int krb = b * SEQ + kp0, krc = TL + b * CTXL;
#define ATT_KR(TT) ((TT) < nband ? krb + 32 * (TT) : krc + 32 * ((TT) - nband))
#define ATT_MASK(TT) ((TT) < nband && ((kp0 + 32 * (TT) + 31 - qoff > 128) || (kp0 + 32 * (TT) - (qoff + 63) < -128)))
        bf16x8 KA[2][2], VA[4], KB[2][2], VB[4];
        att_load(KA, VA, QK, VT, ATT_KR(0), hk, l15, q4);
        for (int tt = 0; tt < nt; tt += 2) {
            if (tt + 1 < nt) att_load(KB, VB, QK, VT, ATT_KR(tt + 1), hk, l15, q4);
            att_tile(KA, VA, QF, Oa, mrun, lrun, ATT_MASK(tt), kp0 + 32 * tt, qoff, l15, q4);
            if (tt + 1 < nt) {
                if (tt + 2 < nt) att_load(KA, VA, QK, VT, ATT_KR(tt + 2), hk, l15, q4);
                att_tile(KB, VB, QF, Oa, mrun, lrun, ATT_MASK(tt + 1), kp0 + 32 * (tt + 1), qoff, l15, q4);
            }
        }
#undef ATT_KR
#undef ATT_MASK
#pragma unroll
        for (int qb = 0; qb < ANQ; ++qb) {
            float l = lrun[qb]; l += __shfl_xor(l, 16); l += __shfl_xor(l, 32);
            const float inv = __builtin_amdgcn_rcpf(l);
            bf16_t* op = O + (size_t)(r0 + 16 * qb + l15) * D + 64 * hq + 4 * q4;
#pragma unroll
            for (int db = 0; db < 4; ++db) { const f32x4 o = Oa[qb][db] * inv; u32x2 wv; wv.x = pk2(o[0], o[1]); wv.y = pk2(o[2], o[3]); *(u32x2*)(op + 16 * db) = wv; }
        }
    }
}

__device__ __forceinline__ int ssm_chunk_row(int d, int b, int k) {
    if (d == 0) return k < 4 ? TL + b * CTXL + 64 * k : b * SEQ + 64 * (k - 4);
    return k < 4 ? TL + b * CTXL + 64 * (3 - k) : b * SEQ + 64 * (67 - k);
}
__device__ __forceinline__ void ssm_s1(const Ctx& c, const bf16_t* __restrict__ H, const bf16_t* __restrict__ ET, float* __restrict__ SLOC) {
    const int l15 = c.lane & 15, q4 = c.lane >> 4, w = c.wid;
    LAS unsigned char* ETs = c.lds;
    LAS unsigned char* Us = c.lds + 17408;
    for (int it = c.bid; it < 256; it += c.nb) {
        const int dg = it >> 1, nh = it & 1, d = dg >> 6, g = dg & 63;
        const int nbk = w >> 1, mp = w & 1;
        f32x4 acc[9];
#pragma unroll
        for (int i = 0; i < 9; ++i) acc[i] = (f32x4){0.f, 0.f, 0.f, 0.f};
        u32x4 pe[2], pu[9];
#define S1_FETCH(KC) do { _Pragma("unroll") for (int q = 0; q < 2; ++q) { const int i = c.tid + 512 * q; const int n = i >> 4, pc = i & 15; \
                pe[q] = __builtin_nontemporal_load((const u32x4*)(ET + ((size_t)dg * 128 + 64 * nh + n) * 1024 + 128 * (KC) + 8 * pc)); } \
            _Pragma("unroll") for (int q = 0; q < 9; ++q) { const int i = c.tid + 512 * q; if (i < 272 * 16) { const int m = i >> 4, pc = i & 15, b = m / 68, k = m - b * 68; \
                pu[q] = *(const u32x4*)(H + ((size_t)g * TA + ssm_chunk_row(d, b, k) + 8 * (KC) + (pc >> 1)) * 16 + 8 * (pc & 1)); } } } while (0)
        S1_FETCH(0);
        for (int kc = 0; kc < 8; ++kc) {
            __syncthreads();
#pragma unroll
            for (int q = 0; q < 2; ++q) { const int i = c.tid + 512 * q; *(LAS u32x4*)(ETs + (i >> 4) * 272 + (i & 15) * 16) = pe[q]; }
#pragma unroll
            for (int q = 0; q < 9; ++q) { const int i = c.tid + 512 * q; if (i < 272 * 16) *(LAS u32x4*)(Us + (i >> 4) * 272 + (i & 15) * 16) = pu[q]; }
            __syncthreads();
            if (kc + 1 < 8) S1_FETCH(kc + 1);
#pragma unroll
            for (int ks = 0; ks < 4; ++ks) {
                const bf16x8 ef = *(const LAS bf16x8*)(ETs + (16 * nbk + l15) * 272 + 64 * ks + 16 * q4);
#pragma unroll
                for (int i = 0; i < 9; ++i) { const int mb = 2 * i + mp; if (mb < 17) { const bf16x8 uf = *(const LAS bf16x8*)(Us + (16 * mb + l15) * 272 + 64 * ks + 16 * q4); acc[i] = mfma16(ef, uf, acc[i]); } }
            }
        }
#undef S1_FETCH
#pragma unroll
        for (int i = 0; i < 9; ++i) { const int mb = 2 * i + mp; if (mb < 17) *(f32x4*)(SLOC + ((size_t)dg * 272 + 16 * mb + l15) * 128 + 64 * nh + 16 * nbk + 4 * q4) = acc[i]; }
    }
    __syncthreads();
}
__device__ __forceinline__ void ssm_s2(const Ctx& c, const float* SLOC, const f32x2* LAML, bf16_t* SIN) {
    const int gt = c.bid * 512 + c.tid;
    if (gt < 2 * 64 * 4 * 64) {
        const int p = gt & 63, b = (gt >> 6) & 3, dg = gt >> 8;
        const f32x2 lm = LAML[dg * 64 + p];
        float sr = 0.f, si = 0.f;
        const f32x2* sl = (const f32x2*)(SLOC + ((size_t)dg * 272 + b * 68) * 128) + p;
        unsigned* so = (unsigned*)(SIN + ((size_t)dg * 272 + b * 68) * 128) + p;
#pragma unroll 4
        for (int k = 0; k < 68; ++k) {
            so[(size_t)k * 64] = pk2(sr, si);
            const f32x2 v = sl[(size_t)k * 64];
            const float nr = lm.x * sr - lm.y * si + v.x, ni = lm.x * si + lm.y * sr + v.y;
            sr = nr; si = ni;
        }
    }
}
__device__ __forceinline__ void ssm_s3(const Args& a, const Ctx& c, const bf16_t* H, const bf16_t* KK, const bf16_t* GT, const float* SLOC, const f32x2* LAML, bf16_t* GACT) {
    const int l15 = c.lane & 15, q4 = c.lane >> 4, w = c.wid;
    LAS unsigned char* U = c.lds;
    const float* dsk = AIN(I_SSMD);
    LAS unsigned char* SINL = c.lds + 139264;
    for (int it = c.bid; it < 64 * 8; it += c.nb) {
        const int g = it >> 3, mg = it & 7, b = mg >> 1, j0 = 32 * (mg & 1);
        __syncthreads();
        for (int i = c.tid; i < 2 * 68 * 32; i += 512) { const int d = i / (68 * 32), r = i - d * (68 * 32);
            *(LAS f32x4*)(U + (size_t)i * 16) = *(const f32x4*)(SLOC + ((size_t)(d * 64 + g) * 272 + b * 68) * 128 + (size_t)r * 4); }
        __syncthreads();
        if (c.tid < 128) { const int d = c.tid >> 6, p = c.tid & 63; const f32x2 lm = LAML[(d * 64 + g) * 64 + p];
            float sr = 0.f, si = 0.f;
            for (int k = 0; k < 68; ++k) {
                const int jj = d ? (67 - k - j0) : (k - 4 - j0);
                if (jj >= 0 && jj < 32) *(LAS unsigned*)(SINL + ((d * 32 + jj) * 128 + 2 * p) * 2) = pk2(sr, si);
                const f32x2 v = *(const LAS f32x2*)(U + ((size_t)(d * 68 + k) * 128 + 2 * p) * 4);
                const float nr = lm.x * sr - lm.y * si + v.x, ni = lm.x * si + lm.y * sr + v.y; sr = nr; si = ni; } }
        __syncthreads();
        for (int i = c.tid; i < 32 * 64 * 2; i += 512) { const int ml = i >> 7, tp = (i >> 1) & 63, hf = i & 1;
            const u32x4 v = *(const u32x4*)(H + ((size_t)g * TA + b * SEQ + 64 * (j0 + ml) + tp) * 16 + 8 * hf);
            *(LAS u32x4*)(U + ml * 2064 + (tp * 16 + 8 * hf) * 2) = v; }
        for (int i = c.tid; i < 4064; i += 512) *(LAS u32x4*)(U + 66048 + i * 16) = *(const u32x4*)(KK + (size_t)g * 127 * 256 + i * 8);
        __syncthreads();
#pragma unroll 1
        for (int par = 0; par < 2; ++par) {
            f32x4 acc[4][2];
#pragma unroll
            for (int i = 0; i < 4; ++i) { acc[i][0] = (f32x4){0.f, 0.f, 0.f, 0.f}; acc[i][1] = acc[i][0]; }
            bf16x8 ua[4], ub[4];
            const int col = 16 * g + 4 * q4; const f32x4 dv = *(const f32x4*)(dsk + col);
            u32x2 hv[4][2];
#pragma unroll
            for (int i = 0; i < 4; ++i)
#pragma unroll
                for (int mb = 0; mb < 2; ++mb) hv[i][mb] = *(const u32x2*)(H + ((size_t)g * TA + (size_t)b * SEQ + 64 * (j0 + 16 * mb + l15) + 8 * w + par + 2 * i) * 16 + 4 * q4);
            LAS unsigned char* u0 = U + l15 * 2064 + 16 * q4;
            LAS unsigned char* kbase = U + 66048 + (8 * w + par + 63 - (q4 >> 1)) * 512 + l15 * 32 + 16 * (q4 & 1);
#pragma unroll 1
            for (int e4 = 0; e4 < 36; e4 += 4) {
#pragma unroll
                for (int sft = 0; sft < 4; ++sft) {
                    const int ksn = e4 + sft, e = ksn - 3;
                    if (ksn < 32) { ua[sft] = *(const LAS bf16x8*)(u0 + 64 * ksn); ub[sft] = *(const LAS bf16x8*)(u0 + 16 * 2064 + 64 * ksn); }
                    if (e <= 31) {
                        const bf16x8 kf = *(const LAS bf16x8*)(kbase - e * 1024);
#pragma unroll
                        for (int i = 0; i < 4; ++i) { const int ks = e + i;
                            if (ks >= 0 && ks <= 31) { acc[i][0] = mfma16(kf, ua[(sft + i + 1) & 3], acc[i][0]); acc[i][1] = mfma16(kf, ub[(sft + i + 1) & 3], acc[i][1]); } }
                    }
                }
            }
            asm volatile("" ::: "memory");
            bf16x8 gA[4], gB[4];
#define S3_GT_LOAD(dst, stp) do { _Pragma("unroll") for (int i = 0; i < 4; ++i) \
                dst[i] = *(const bf16x8*)(GT + ((size_t)(((stp) >> 2) * 64 + g) * 1024 + 16 * (8 * w + par + 2 * i) + l15) * 128 + 32 * ((stp) & 3) + 8 * q4); } while (0)
#define S3_STEP(cur, stp) do { const bf16x8 s0_ = *(const LAS bf16x8*)(SINL + ((((stp) >> 2) * 32 + l15) * 128 + 32 * ((stp) & 3) + 8 * q4) * 2), s1_ = *(const LAS bf16x8*)(SINL + ((((stp) >> 2) * 32 + 16 + l15) * 128 + 32 * ((stp) & 3) + 8 * q4) * 2); \
                _Pragma("unroll") for (int i = 0; i < 4; ++i) { acc[i][0] = mfma16(cur[i], s0_, acc[i][0]); acc[i][1] = mfma16(cur[i], s1_, acc[i][1]); } } while (0)
            S3_GT_LOAD(gA, 0);
            S3_GT_LOAD(gB, 1); S3_STEP(gA, 0);
            S3_GT_LOAD(gA, 2); S3_STEP(gB, 1);
            S3_GT_LOAD(gB, 3); S3_STEP(gA, 2);
            S3_GT_LOAD(gA, 4); S3_STEP(gB, 3);
            S3_GT_LOAD(gB, 5); S3_STEP(gA, 4);
            S3_GT_LOAD(gA, 6); S3_STEP(gB, 5);
            S3_GT_LOAD(gB, 7); S3_STEP(gA, 6);
            S3_STEP(gB, 7);
#undef S3_STEP
#undef S3_GT_LOAD
#pragma unroll
            for (int i = 0; i < 4; ++i) { const int t = 8 * w + par + 2 * i;
#pragma unroll
                for (int mb = 0; mb < 2; ++mb) { const size_t row = (size_t)b * SEQ + 64 * (j0 + 16 * mb + l15) + t; const f32x4 y = acc[i][mb]; const u32x2 hq_ = hv[i][mb];
                    const float o0 = gelu_tanh(y[0] + dv[0] * bflo(hq_.x)), o1 = gelu_tanh(y[1] + dv[1] * bfhi(hq_.x)), o2 = gelu_tanh(y[2] + dv[2] * bflo(hq_.y)), o3 = gelu_tanh(y[3] + dv[3] * bfhi(hq_.y));
                    u32x2 ov; ov.x = pk2(o0, o1); ov.y = pk2(o2, o3); *(u32x2*)(GACT + row * D + col) = ov; } }
        }
    }
    __syncthreads();
}

__device__ __forceinline__ void gmlp_stats(const Ctx& c, const bf16_t* Z, float* VSTAT) {
    for (int row = c.gw; row < TL; row += c.ngw) {
        const u32x4* zr = (const u32x4*)(Z + (size_t)row * 4096 + 2048) + c.lane;
        float v[32]; float s = 0.f;
#pragma unroll
        for (int j = 0; j < 4; ++j) { const u32x4 q = zr[64 * j];
#pragma unroll
            for (int e = 0; e < 4; ++e) { v[j * 8 + 2 * e] = bflo(q[e]); v[j * 8 + 2 * e + 1] = bfhi(q[e]); s += v[j * 8 + 2 * e] + v[j * 8 + 2 * e + 1]; } }
        const float mean = wave_sum(s) * (1.f / 2048.f); float s2 = 0.f;
#pragma unroll
        for (int j = 0; j < 32; ++j) { const float dlt = v[j] - mean; s2 += dlt * dlt; }
        const float rstd = __builtin_amdgcn_rsqf(wave_sum(s2) * (1.f / 2048.f) + LN_EPS);
        if (c.lane == 0) { VSTAT[2 * row] = mean; VSTAT[2 * row + 1] = rstd; }
    }
}
__device__ __forceinline__ void gmlp_spatial(const Args& a, const Ctx& c, bf16_t* Z, const float* VSTAT, const bf16_t* WS16, bf16_t* dry = nullptr) {
    const int l15 = c.lane & 15, q4 = c.lane >> 4, w = c.wid;
    LAS bf16_t* VTL = (LAS bf16_t*)c.lds;
    const float* lg = AIN(I_GLNG); const float* lb = AIN(I_GLNB); const float* bs = AIN(I_GBS);
    u32x4 zpre[8];
#define SP_FETCH(IT) do { const int ch_ = (IT) >> 3, hh_ = (IT) & 7; _Pragma("unroll") for (int k = 0; k < 8; ++k) { const int i = c.tid + 512 * k; \
        zpre[k] = *(const u32x4*)(Z + (size_t)(ch_ * 128 + (i >> 5)) * 4096 + 2048 + 256 * hh_ + (i & 31) * 8); } } while (0)
    if (c.bid < 128 * 8) SP_FETCH(c.bid);
    for (int it = c.bid; it < 128 * 8; it += c.nb) {
        const int ch = it >> 3, hh = it & 7;
        __syncthreads();
#pragma unroll
        for (int k = 0; k < 8; ++k) { const int i = c.tid + 512 * k; const int q = i >> 5, c8 = (i & 31) * 8; const int row = ch * 128 + q;
            const u32x4 zv = zpre[k];
            const float mean = VSTAT[2 * row] * (1.f / 2048.f), rstd = __builtin_amdgcn_rsqf(fmaxf(VSTAT[2 * row + 1] * (1.f / 2048.f) - mean * mean, 0.f) + LN_EPS);
#pragma unroll
            for (int e = 0; e < 4; ++e) { const int cc = c8 + 2 * e; const int gc = 256 * hh + cc;
                const float v0 = (bflo(zv[e]) - mean) * rstd * lg[gc] + lb[gc], v1 = (bfhi(zv[e]) - mean) * rstd * lg[gc + 1] + lb[gc + 1];
                VTL[cc * 136 + q] = (bf16_t)f2bf(v0); VTL[(cc + 1) * 136 + q] = (bf16_t)f2bf(v1); } }
        __syncthreads();
        if (it + c.nb < 128 * 8) SP_FETCH(it + c.nb);
        bf16x8 WF[4];
#pragma unroll
        for (int ks = 0; ks < 4; ++ks) WF[ks] = *(const bf16x8*)(WS16 + ((size_t)hh * 128 + 16 * w + l15) * 128 + 32 * ks + 8 * q4);
        const float bsp = bs[hh * 128 + 16 * w + l15];
        const size_t row = (size_t)ch * 128 + 16 * w + l15;
        u32x2 upre[16];
#pragma unroll
        for (int cb = 0; cb < 16; ++cb) upre[cb] = *(const u32x2*)(Z + row * 4096 + 256 * hh + 16 * cb + 4 * q4);
#pragma unroll
        for (int cb = 0; cb < 16; ++cb) {
            f32x4 acc = (f32x4){0.f, 0.f, 0.f, 0.f};
#pragma unroll
            for (int ks = 0; ks < 4; ++ks) { const bf16x8 vf = *(const LAS bf16x8*)(VTL + (16 * cb + l15) * 136 + 32 * ks + 8 * q4); acc = mfma16(vf, WF[ks], acc); }
            bf16_t* up = Z + row * 4096 + 256 * hh + 16 * cb + 4 * q4;
            const u32x2 uv = upre[cb];
            u32x2 ov; ov.x = pk2(bflo(uv.x) * (acc[0] + bsp), bfhi(uv.x) * (acc[1] + bsp)); ov.y = pk2(bflo(uv.y) * (acc[2] + bsp), bfhi(uv.y) * (acc[3] + bsp));
            if (dry) *(u32x2*)(dry + row * 2048 + 256 * hh + 16 * cb + 4 * q4) = ov; else *(u32x2*)up = ov;
        }
    }
#undef SP_FETCH
    __syncthreads();
}

#define ws ((unsigned char*)kargs()->ws)
#define MODS ((float*)(ws + WS_MODS))
#define RESL ((float*)kargs()->out)
#define RESC ((float*)(ws + WS_RESC))
#define H ((bf16_t*)(ws + WS_H))
#define ABUF ((bf16_t*)(ws + WS_ABUF))
#define HID ((bf16_t*)(ws + WS_HID))
#define WUP ((bf16_t*)(ws + WS_WUP))
#define WDN ((bf16_t*)(ws + WS_WDN))
#ifndef EXPM
#define EXPM 0
#endif
#define WS_PART (WS_ABUF + (size_t)128 * 1024 * 1024)
#define GEMM_SPLITK(Eobj, Ap, Bp, K_, lda_, ldb_) do { pg8::Gemm g_{Ap, Bp, 1024, 1024 * ((K_) / 256), 256, lda_, ldb_, 256, 2, 3, 256}; pg8::StaticOrder S_; S_.init(1024, 1024 * ((K_) / 256), c.nb, c.bid); FRESH(); pg8::gemm_phase<EpiAtomic>(c.lds, g_, S_, Eobj, c.tid); } while (0)
#define FRESH() do { int t_ = threadIdx.x; asm volatile("" : "+v"(t_)); int b_ = blockIdx.x; asm volatile("" : "+s"(b_)); int n_ = gridDim.x; asm volatile("" : "+s"(n_)); c.tid = t_; c.lane = t_ & 63; c.wid = __builtin_amdgcn_readfirstlane(t_ >> 6); c.bid = b_; c.nb = n_; c.gw = b_ * 8 + c.wid; c.ngw = n_ * 8; } while (0)
#define GSYNC() do { XcdBarrier xb_; xb_.bar = (unsigned*)(ws + WS_BAR); xb_.x = xb_xcc_id(); xb_.st = (volatile LAS unsigned*)(c.lds + 135168); xcd_barrier(xb_); if (EXPM & 8) xcd_barrier(xb_); FRESH(); } while (0)
#define REP2(bit, stmt) do { stmt; if (EXPM & (bit)) { FRESH(); stmt; } } while (0)
#define GEMM(EpiT, Eobj, Ap, Bp, M_, N_, K_, lda_, ldb_, apn_) do { pg8::Gemm g_{Ap, Bp, M_, N_, K_, lda_, ldb_, apn_, 0, 0x7fffffff, 0}; pg8::StaticOrder S_; S_.init(M_, (N_), c.nb, c.bid); FRESH(); pg8::gemm_phase<EpiT>(c.lds, g_, S_, Eobj, c.tid); } while (0)

#define LNSTAT(pt) ((float*)(ws + WS_LNSTAT) + (size_t)(pt) * TL * 2)
#define LNCNT(pt) ((unsigned*)(ws + WS_LNCNT) + (size_t)(pt) * 64 * 64)
template <int layer> __device__ __forceinline__ void run_layer(const Args& a, Ctx& c) {
        const float* mods = MODS + layer * 5 * 6144;
        const int Mrows = layer < 2 ? TA : TL;
        if (layer == 0) {
            pool_mix(a, c, mods, HID);
            GSYNC();
            EpiResLn E{RESL, mods, MOD_GT1, AIN(I_LN1G) + layer * D, AIN(I_LN1B) + layer * D, H, mods, MOD_SH2, MOD_SC2, LNSTAT(0), LNCNT(0), 0, AIN(I_X), AIN(I_POOLB), AIN(I_POOLS)};
            GEMM(EpiResLn, E, HID, (const bf16_t*)(ws + WS_WPOOL), TL, 1024, 256, 1024, 256, 256);
            { EpiRes<0> Ec{AIN(I_X), AIN(I_CTX), RESL, RESC, mods, MOD_GT1, AIN(I_POOLB), AIN(I_POOLS), TL};
              GEMM(EpiRes<0>, Ec, HID + (size_t)TL * D, (const bf16_t*)(ws + WS_WPOOL), 1024, 1024, 256, 1024, 256, 256); }
            GSYNC();
            ln_pass(c, TL, TA, RESL, RESC, AIN(I_LN1G) + layer * D, AIN(I_LN1B) + layer * D, H, mods, MOD_SH2, MOD_SC2, nullptr, 0, mods, MOD_GT1);
            GSYNC();
        } else if (layer == 1) {
            EpiRope E{(bf16_t*)(ws + WS_QK), (bf16_t*)(ws + WS_VT), (const float*)(ws + WS_ROPE)};
            GEMM(EpiRope, E, H, (const bf16_t*)(ws + WS_WQKV), TA, 1536, 1024, 1024, 1024, 0);
            GSYNC();
            attn_phase(a, c, (const bf16_t*)(ws + WS_QK), (const bf16_t*)(ws + WS_VT), HID);
            GSYNC();
            EpiResLn E2{RESL, mods, MOD_GT1, AIN(I_LN1G) + layer * D, AIN(I_LN1B) + layer * D, H, mods, MOD_SH2, MOD_SC2, LNSTAT(2 * layer), LNCNT(2 * layer), 0, RESL, nullptr, nullptr};
            GEMM(EpiResLn, E2, HID, (const bf16_t*)(ws + WS_WO), TL, 1024, 1024, 1024, 1024, 0);
            { EpiAtomic Ea{(float*)(ws + WS_PART)}; GEMM_SPLITK(Ea, HID + (size_t)TL * D, (const bf16_t*)(ws + WS_WO), 1024, 1024, 1024); }
            GSYNC();
            ln_pass(c, TL, TA, RESL, RESC, AIN(I_LN1G) + layer * D, AIN(I_LN1B) + layer * D, H, mods, MOD_SH2, MOD_SC2, (const float*)(ws + WS_PART), 4, mods, MOD_GT1);
            GSYNC();
        } else if (layer == 2) {
            ssm_s1(c, H, (const bf16_t*)(ws + WS_ET), (float*)(ws + WS_SLOC));
            GSYNC();
            ssm_s3(a, c, H, (const bf16_t*)(ws + WS_KK), (const bf16_t*)(ws + WS_GT), (const float*)(ws + WS_SLOC), (const f32x2*)(ws + WS_LAML), (bf16_t*)(ws + WS_GACT));
            GSYNC();
            { EpiGluLn E{RESL, mods, MOD_GT1, AIN(I_LN1G) + layer * D, AIN(I_LN1B) + layer * D, H, mods, MOD_SH2, MOD_SC2, LNSTAT(2 * layer), LNCNT(2 * layer)};
#pragma unroll 1
              for (int r = 0; r < 2; ++r) { pg8::Gemm g_{(const bf16_t*)(ws + WS_GACT), (const bf16_t*)(ws + WS_WGLU), TL, 2048, 1024, 1024, 1024, 0, 0, 0x7fffffff, 0};
                FRESH(); pg8::StaticOrder S_; S_.init(TL, 2048, c.nb, c.bid); S_.fixed_pm = 32 * r + (c.bid >> 3); S_.fixed_pn = c.bid & 7;
                pg8::gemm_phase<EpiGluLn>(c.lds, g_, S_, E, c.tid); } }
            GSYNC();
        } else {
            conv_weight(c, AIN(I_WUP) + (size_t)layer * 1024 * F2, 1024, F2, WUP, 0);
            conv_weight(c, AIN(I_WDN) + (size_t)layer * FH * 1024, FH, 1024, WDN, 0);
            __syncthreads();
            EpiBf16<2> E{ABUF, 4096, AIN(I_GBIN), (float*)(ws + WS_VSTAT)};
            GEMM(EpiBf16<2>, E, H, (const bf16_t*)(ws + WS_WGIN), TL, 4096, 1024, 1024, 1024, 0);
            GSYNC();
            gmlp_spatial(a, c, ABUF, (const float*)(ws + WS_VSTAT), (const bf16_t*)(ws + WS_WS16));
            GSYNC();
            EpiResLn E2{RESL, mods, MOD_GT1, AIN(I_LN1G) + layer * D, AIN(I_LN1B) + layer * D, H, mods, MOD_SH2, MOD_SC2, LNSTAT(2 * layer), LNCNT(2 * layer), 0, RESL, nullptr, nullptr};
            GEMM(EpiResLn, E2, ABUF, (const bf16_t*)(ws + WS_WGOUT), TL, 1024, 2048, 4096, 2048, 0);
            GSYNC();
        }
        { EpiBf16<0> E{ABUF, F2, nullptr, nullptr}; GEMM(EpiBf16<0>, E, H, WUP, Mrows, F2, 1024, 1024, 1024, 0); }
        GSYNC();
        conv_gate(c, Mrows, ABUF, HID, AIN(I_CONVW) + (size_t)layer * 3 * F2, AIN(I_CONVB) + (size_t)layer * F2);
        GSYNC();
        { EpiResLn E{RESL, mods, MOD_GT2, AIN(I_LN2G) + layer * D, AIN(I_LN2B) + layer * D, layer < 3 ? H : (bf16_t*)nullptr, mods + 5 * 6144, MOD_SH1, MOD_SC1, LNSTAT(2 * layer + 1), LNCNT(2 * layer + 1), layer == 1 ? 1 : 0, RESL, nullptr, nullptr};
          GEMM(EpiResLn, E, HID, WDN, TL, 1024, FH, FH, FH, 0); }
        if (layer < 2) { EpiAtomic Ea{(float*)(ws + WS_PART)}; GEMM_SPLITK(Ea, HID + (size_t)TL * FH, WDN, FH, FH, FH); }
        if (layer < 3) GSYNC();
        if (layer < 2) {
            ln_pass(c, TL, TA, RESL, RESC, AIN(I_LN2G) + layer * D, AIN(I_LN2B) + layer * D, H, mods + 5 * 6144, MOD_SH1, MOD_SC1, (const float*)(ws + WS_PART), 11, mods, MOD_GT2, layer == 1 ? 1 : 0);
            conv_weight(c, AIN(I_WUP) + (size_t)(layer + 1) * 1024 * F2, 1024, F2, WUP, 0);
            conv_weight(c, AIN(I_WDN) + (size_t)(layer + 1) * FH * 1024, FH, 1024, WDN, 0);
            if (layer == 1) ssm_tables(a, c);
            GSYNC();
        }
}

__global__ void __launch_bounds__(512) hidt_fwd(Args a) {
    extern __shared__ __attribute__((aligned(16))) unsigned char lds_raw[];
    cg::grid_group grid = cg::this_grid();
    Ctx c; c.tid = threadIdx.x; c.lane = c.tid & 63; c.wid = __builtin_amdgcn_readfirstlane(c.tid >> 6); c.bid = blockIdx.x; c.nb = gridDim.x;
    c.gw = c.bid * 8 + c.wid; c.ngw = c.nb * 8; c.lds = (LAS unsigned char*)lds_raw;

    if (c.bid == 0) for (int i = c.tid; i < XCD_BAR_WORDS; i += 512) ((unsigned*)(ws + WS_BAR))[i] = 0u;
    if (c.tid < 32) ((LAS unsigned*)(c.lds + 135168))[c.tid] = 0u;
    REP2(4, phase0(a, c));
    __syncthreads();
    grid.sync();
    (void)xcd_barrier_post((unsigned*)(ws + WS_BAR), (volatile LAS unsigned*)(c.lds + 135168));
    FRESH();
    run_layer<0>(a, c);
    run_layer<1>(a, c);
    run_layer<2>(a, c);
    run_layer<3>(a, c);
}

#undef ws
#undef MODS
#undef RESL
#undef RESC
#undef H
#undef ABUF
#undef HID
#undef WUP
#undef WDN
extern "C" void kernel_launch(void* const* d_in, const int* in_sizes, int n_in, void* d_out, int out_size, void* d_ws, size_t ws_size, hipStream_t stream) {
    static int grid = 0;
    if (grid == 0) {
        if (n_in != 37 || ws_size < WS_END) { fprintf(stderr, "kernel_launch: unexpected inputs (n_in %d, ws %zu, need %zu)\n", n_in, ws_size, (size_t)WS_END); grid = -1; return; }
        int dev = 0, cus = 0, per_cu = 0;
        (void)hipGetDevice(&dev);
        (void)hipDeviceGetAttribute(&cus, hipDeviceAttributeMultiprocessorCount, dev);
        if (hipFuncSetAttribute((const void*)hidt_fwd, hipFuncAttributeMaxDynamicSharedMemorySize, LDS_BYTES) != hipSuccess) { fprintf(stderr, "kernel_launch: hipFuncSetAttribute failed\n"); grid = -1; return; }
        if (hipOccupancyMaxActiveBlocksPerMultiprocessor(&per_cu, (const void*)hidt_fwd, 512, LDS_BYTES) != hipSuccess || per_cu < 1) { fprintf(stderr, "kernel_launch: occupancy query says %d\n", per_cu); per_cu = 1; }
        (void)hipGetLastError();
        grid = cus;
    }
    if (grid < 0) return;
    Args a{};
    for (int i = 0; i < 37; ++i) a.in[i] = (const float*)d_in[i];
    a.out = (float*)d_out; a.ws = (unsigned char*)d_ws;
    void* args[] = {&a};
    hipError_t e = hipLaunchCooperativeKernel((const void*)hidt_fwd, dim3(grid), dim3(512), args, LDS_BYTES, stream);
    if (e != hipSuccess) fprintf(stderr, "cooperative launch failed: %s (grid %d)\n", hipGetErrorString(e), grid);
}
```
